# Optimizing an MI355X kernel written in HIP

```python
import jax, jax.numpy as jnp
from jax import lax
import numpy as np

D_MODEL = 2048
BATCH = 4
SEQ = 2048
DEPTH = 1

N_META = 16
GRID_W = 64
MIX_WIDTH = D_MODEL
N_HEADS = 16
HEAD_DIM = 64
ATTN_WIDTH = N_HEADS * HEAD_DIM
CONV_WIDTH = MIX_WIDTH - ATTN_WIDTH
CONV_K = 3
WIN_ROWS = 8
WIN_COLS = 16
N_GROUPS = 4
EXPERTS_PER_GROUP = 8
N_EXPERTS = N_GROUPS * EXPERTS_PER_GROUP
TOP_K = 2
EXPERT_FF = 1024
MOE_BLOCK = 128
EPS = 1e-6

PROJ_WIDTHS = (ATTN_WIDTH, ATTN_WIDTH, ATTN_WIDTH, CONV_WIDTH, CONV_WIDTH, CONV_WIDTH)
PROJ_SPLITS = tuple(int(s) for s in np.cumsum(PROJ_WIDTHS)[:-1])
PROJ_TOTAL = int(sum(PROJ_WIDTHS))

kernel_name = "hymba_na_shortconv_hmoe_encoder"


def rms_norm(x, w):
    xf = x.astype(jnp.float32)
    y = xf * lax.rsqrt(jnp.mean(xf * xf, axis=-1, keepdims=True) + EPS)
    return (y * w.astype(jnp.float32)).astype(x.dtype)


def neighbourhood_attention(q, k, v, rel_bias, meta_bias):
    bsz, length, nh, hd = q.shape
    rows = (length - N_META) // GRID_W
    wr = min(WIN_ROWS, rows)
    scale = hd ** -0.5
    qf = q.astype(jnp.float32) * scale
    kf = k.astype(jnp.float32)
    vf = v.astype(jnp.float32)
    qm, km, vm = qf[:, :N_META], kf[:, :N_META], vf[:, :N_META]
    qg = qf[:, N_META:].reshape(bsz, rows, GRID_W, nh, hd)
    kg = kf[:, N_META:].reshape(bsz, rows, GRID_W, nh, hd)
    vg = vf[:, N_META:].reshape(bsz, rows, GRID_W, nh, hd)

    r = jnp.arange(rows)
    c = jnp.arange(GRID_W)
    row_start = jnp.clip(r - wr // 2, 0, rows - wr)
    row_idx = row_start[:, None] + jnp.arange(wr)[None, :]
    col_start = jnp.clip(c - WIN_COLS // 2, 0, GRID_W - WIN_COLS)
    col_mask = (c[None, :] >= col_start[:, None]) & (c[None, :] < col_start[:, None] + WIN_COLS)

    k_rows = kg[:, row_idx]
    v_rows = vg[:, row_idx]

    dr = row_idx - r[:, None] + (WIN_ROWS - 1)
    dc = jnp.clip(c[None, :] - c[:, None], -(WIN_COLS - 1), WIN_COLS - 1) + (WIN_COLS - 1)
    bias = rel_bias.astype(jnp.float32)[:, dr[:, None, :, None], dc[None, :, None, :]]
    bias = jnp.where(col_mask[None, None, :, None, :], bias, -jnp.inf)

    s_grid = jnp.einsum('brqhd,brwkhd->bhrqwk', qg, k_rows) + bias[None]
    s_meta = jnp.einsum('brqhd,bmhd->bhrqm', qg, km) + meta_bias.astype(jnp.float32)[None, :, None, None, :]
    s = jnp.concatenate([s_grid.reshape(bsz, nh, rows, GRID_W, wr * GRID_W), s_meta], axis=-1)
    p = jax.nn.softmax(s, axis=-1)
    p_grid = p[..., :wr * GRID_W].reshape(bsz, nh, rows, GRID_W, wr, GRID_W)
    p_meta = p[..., wr * GRID_W:]
    o_grid = (jnp.einsum('bhrqwk,brwkhd->brqhd', p_grid, v_rows)
              + jnp.einsum('bhrqm,bmhd->brqhd', p_meta, vm))
    o_grid = o_grid.reshape(bsz, rows * GRID_W, nh, hd)

    p_mm = jax.nn.softmax(jnp.einsum('bmhd,bnhd->bhmn', qm, km), axis=-1)
    o_meta = jnp.einsum('bhmn,bnhd->bmhd', p_mm, vm)
    return jnp.concatenate([o_meta, o_grid], axis=1).astype(q.dtype)


def short_conv_mixer(gate_b, gate_c, h, conv_w):
    u = gate_c * h
    up = jnp.pad(u, ((0, 0), (1, 1), (0, 0)))
    y = up[:, :-2] * conv_w[0] + up[:, 1:-1] * conv_w[1] + up[:, 2:] * conv_w[2]
    return gate_b * y


def hierarchical_moe(x, w_rg, b_rg, w_re, b_re, w_gate, w_up, w_down):
    t, d = x.shape
    xf = x.astype(jnp.float32)
    g_prob = jax.nn.softmax(xf @ w_rg.astype(jnp.float32) + b_rg.astype(jnp.float32), axis=-1)
    g_idx = jnp.argmax(g_prob, axis=-1).astype(jnp.int32)
    g_w = jnp.max(g_prob, axis=-1)
    e_logits = (xf @ w_re.astype(jnp.float32) + b_re.astype(jnp.float32)).reshape(t, N_GROUPS, EXPERTS_PER_GROUP)
    e_logits = e_logits[jnp.arange(t), g_idx]
    top_p, top_j = lax.top_k(jax.nn.softmax(e_logits, axis=-1), TOP_K)
    weights = g_w[:, None] * top_p / jnp.sum(top_p, axis=-1, keepdims=True)
    experts = g_idx[:, None] * EXPERTS_PER_GROUP + top_j.astype(jnp.int32)

    n_assign = t * TOP_K
    e_flat = experts.reshape(-1)
    w_flat = weights.reshape(-1)
    tok_flat = jnp.repeat(jnp.arange(t, dtype=jnp.int32), TOP_K)
    order = jnp.argsort(e_flat)
    e_sorted = e_flat[order]
    counts = jnp.bincount(e_flat, length=N_EXPERTS)
    padded = (counts + MOE_BLOCK - 1) // MOE_BLOCK * MOE_BLOCK
    start_sorted = jnp.cumsum(counts) - counts
    seg_end = jnp.cumsum(padded)
    start_pad = seg_end - padded
    dest = start_pad[e_sorted] + (jnp.arange(n_assign) - start_sorted[e_sorted])
    n_blocks = (n_assign + N_EXPERTS * (MOE_BLOCK - 1) + MOE_BLOCK - 1) // MOE_BLOCK
    n_rows = n_blocks * MOE_BLOCK
    tok_buf = jnp.zeros((n_rows,), jnp.int32).at[dest].set(tok_flat[order])
    w_buf = jnp.zeros((n_rows,), jnp.float32).at[dest].set(w_flat[order])
    x_buf = x[tok_buf].reshape(n_blocks, MOE_BLOCK, d)
    block_expert = jnp.minimum(
        jnp.searchsorted(seg_end, jnp.arange(n_blocks) * MOE_BLOCK, side='right'), N_EXPERTS - 1)

    def expert_block(args):
        xb, e = args
        hb = jax.nn.silu(xb @ w_gate[e]) * (xb @ w_up[e])
        return hb @ w_down[e]

    y_buf = lax.map(expert_block, (x_buf, block_expert)).reshape(n_rows, d)
    y_buf = y_buf * w_buf[:, None].astype(y_buf.dtype)
    return jnp.zeros_like(x).at[tok_buf].add(y_buf.astype(x.dtype))


def setup_inputs(seed: int = 0) -> dict:
    key = jax.random.key(seed)
    ks = jax.random.split(key, 24)
    f32 = jnp.float32
    nrm = lambda k, shape, s: jax.random.normal(k, shape, f32) * s
    return {
        "x": nrm(ks[0], (BATCH, SEQ, D_MODEL), 1.0),
        "meta_tokens": nrm(ks[1], (N_META, D_MODEL), 1.0),
        "mix_norm_w": 1.0 + nrm(ks[2], (DEPTH, D_MODEL), 0.02),
        "w_in": nrm(ks[3], (DEPTH, D_MODEL, PROJ_TOTAL), D_MODEL ** -0.5),
        "q_norm_w": 1.0 + nrm(ks[4], (DEPTH, HEAD_DIM), 0.02),
        "k_norm_w": 1.0 + nrm(ks[5], (DEPTH, HEAD_DIM), 0.02),
        "rel_bias": nrm(ks[6], (DEPTH, N_HEADS, 2 * WIN_ROWS - 1, 2 * WIN_COLS - 1), 0.1),
        "meta_bias": nrm(ks[7], (DEPTH, N_HEADS, N_META), 0.1),
        "conv_w": nrm(ks[8], (DEPTH, CONV_K, CONV_WIDTH), CONV_K ** -0.5),
        "attn_out_norm_w": 1.0 + nrm(ks[9], (DEPTH, ATTN_WIDTH), 0.02),
        "conv_out_norm_w": 1.0 + nrm(ks[10], (DEPTH, CONV_WIDTH), 0.02),
        "w_out": nrm(ks[11], (DEPTH, MIX_WIDTH, D_MODEL), MIX_WIDTH ** -0.5),
        "ffn_norm_w": 1.0 + nrm(ks[12], (DEPTH, D_MODEL), 0.02),
        "w_router_group": nrm(ks[13], (DEPTH, D_MODEL, N_GROUPS), D_MODEL ** -0.5),
        "b_router_group": nrm(ks[14], (DEPTH, N_GROUPS), 0.01),
        "w_router_expert": nrm(ks[15], (DEPTH, D_MODEL, N_EXPERTS), D_MODEL ** -0.5),
        "b_router_expert": nrm(ks[16], (DEPTH, N_EXPERTS), 0.01),
        "w_gate": nrm(ks[17], (DEPTH, N_EXPERTS, D_MODEL, EXPERT_FF), D_MODEL ** -0.5),
        "w_up": nrm(ks[18], (DEPTH, N_EXPERTS, D_MODEL, EXPERT_FF), D_MODEL ** -0.5),
        "w_down": nrm(ks[19], (DEPTH, N_EXPERTS, EXPERT_FF, D_MODEL), EXPERT_FF ** -0.5),
    }


def reference(x, meta_tokens, mix_norm_w, w_in, q_norm_w, k_norm_w, rel_bias, meta_bias, conv_w,
              attn_out_norm_w, conv_out_norm_w, w_out, ffn_norm_w, w_router_group, b_router_group,
              w_router_expert, b_router_expert, w_gate, w_up, w_down):
    bsz, seq, d = x.shape
    meta = jnp.broadcast_to(meta_tokens[None].astype(x.dtype), (bsz, N_META, d))
    h = jnp.concatenate([meta, x], axis=1)
    length = h.shape[1]
    for l in range(DEPTH):
        xn = rms_norm(h, mix_norm_w[l])
        proj = xn @ w_in[l]
        q, k, v, gate_b, gate_c, hc = jnp.split(proj, PROJ_SPLITS, axis=-1)
        q = rms_norm(q.reshape(bsz, length, N_HEADS, HEAD_DIM), q_norm_w[l])
        k = rms_norm(k.reshape(bsz, length, N_HEADS, HEAD_DIM), k_norm_w[l])
        v = v.reshape(bsz, length, N_HEADS, HEAD_DIM)
        a = neighbourhood_attention(q, k, v, rel_bias[l], meta_bias[l]).reshape(bsz, length, ATTN_WIDTH)
        c = short_conv_mixer(gate_b, gate_c, hc, conv_w[l])
        mixed = jnp.concatenate([rms_norm(a, attn_out_norm_w[l]), rms_norm(c, conv_out_norm_w[l])], axis=-1)
        h = h + mixed @ w_out[l]
        hn = rms_norm(h, ffn_norm_w[l]).reshape(bsz * length, d)
        h = h + hierarchical_moe(hn, w_router_group[l], b_router_group[l], w_router_expert[l],
                                 b_router_expert[l], w_gate[l], w_up[l], w_down[l]).reshape(bsz, length, d)
    return h[:, N_META:]
```

```cpp
#include <hip/hip_runtime.h>
#include <cstdint>
#include <cstdio>

#ifndef N_LAUNCH_SPLIT
#define N_LAUNCH_SPLIT 0
#endif

typedef unsigned short bf16_t;
typedef short bf16x8 __attribute__((ext_vector_type(8)));
typedef short s16x4 __attribute__((ext_vector_type(4)));
typedef float f32x4 __attribute__((ext_vector_type(4)));
typedef float f32x2 __attribute__((ext_vector_type(2)));
typedef unsigned u32x4 __attribute__((ext_vector_type(4)));
typedef unsigned u32x2 __attribute__((ext_vector_type(2)));
typedef __bf16 bf2_t __attribute__((ext_vector_type(2)));
#define LAS __attribute__((address_space(3)))

constexpr int T = 8192, D = 2048, PROJ = 6144, NE = 32, FF = 1024, SEQ = 2048;
constexpr float EPS = 1e-6f;
constexpr int SMEM_BYTES = 155648;
constexpr int HROWS = 24576;
constexpr int SSW = 20;

struct Params {
    const float *x, *meta, *mix_w, *w_in, *qn_w, *kn_w, *rel_bias, *meta_bias, *conv_w, *an_w, *cn_w, *w_out, *ffn_w, *w_rg, *b_rg, *w_re, *b_re, *w_gate, *w_up, *w_down;
    float* out;
    unsigned* bar;
    int* cnt;
    int* done;
    bf16_t* xn;
    bf16_t* proj;
    float* metaproj;
    bf16_t* wrt;
    bf16_t* wib;
    bf16_t* wob;
    bf16_t* mixed;
    float* ss;
    bf16_t* hw;
    bf16_t* h2b;
    float* rr_list;
    int* asg;
    int* tok_list;
    float* w_list;
    bf16_t* hbuf;
    bf16_t* ybuf;
};

__device__ __forceinline__ unsigned pk_bf16(float a, float b) { f32x2 v = {a, b}; bf2_t r = __builtin_convertvector(v, bf2_t); return __builtin_bit_cast(unsigned, r); }
__device__ __forceinline__ float bf_lo(unsigned u) { return __builtin_bit_cast(float, u << 16); }
__device__ __forceinline__ float bf_hi(unsigned u) { return __builtin_bit_cast(float, u & 0xffff0000u); }
__device__ __forceinline__ float wave_sum(float v) {
#pragma unroll
    for (int o = 32; o > 0; o >>= 1) v += __shfl_xor(v, o);
    return v;
}

__device__ __forceinline__ int tid_of(int wv);
#define XB_TMO      128
#define XB_XCNT(j)  (256  + 64 * (j))
#define XB_XSUB(j)  (1280 + 64 * (j))
#define XB_XGEN(j)  (2304 + 64 * (j))
#define XB_TOP      3328
#define XB_TOPGEN   3392
#define XCD_BAR_WORDS 3456
#define XB_SPIN_CAP (1u << 22)
__device__ __forceinline__ unsigned xb_ld(unsigned* p)              { return __hip_atomic_load(p, __ATOMIC_RELAXED, __HIP_MEMORY_SCOPE_AGENT); }
__device__ __forceinline__ unsigned xb_add(unsigned* p, unsigned v) { return __hip_atomic_fetch_add(p, v, __ATOMIC_RELAXED, __HIP_MEMORY_SCOPE_AGENT); }
__device__ __forceinline__ unsigned xb_xcc_id() { return (unsigned)__builtin_amdgcn_s_getreg((3 << 11) | 20) & 0xFu; }
#define XB_SPIN(cond, bar) do { unsigned _sp = 0; while (cond) { __builtin_amdgcn_s_sleep(1); \
    if ((++_sp & 255u) == 0u) { if (xb_ld(&(bar)[XB_TMO])) break; if (_sp > XB_SPIN_CAP) { atomicAdd(&(bar)[XB_TMO], 1u); break; } } } } while (0)
struct XcdBarrier { unsigned* bar; unsigned x; volatile LAS unsigned* st; };
__device__ __forceinline__ XcdBarrier xcd_barrier_post(unsigned* bar, volatile LAS unsigned* st, const int wv) {
    XcdBarrier b; b.bar = bar; b.x = xb_xcc_id(); b.st = st;
    if (tid_of(wv) == 0) (void)xb_add(&bar[XB_XCNT(b.x)], 1u);
    return b;
}
__device__ __forceinline__ void xcd_barrier_complete(unsigned* bar, unsigned x, unsigned& nloc, unsigned& nx) {
    const unsigned G = gridDim.x * gridDim.y * gridDim.z;
    unsigned sum, cnt, mine, sp = 0u;
    for (;;) {
        sum = 0u; cnt = 0u; mine = 0u;
#pragma unroll
        for (unsigned j = 0; j < 16; ++j) { const unsigned c = xb_ld(&bar[XB_XCNT(j)]); sum += c; cnt += (c > 0u) ? 1u : 0u; mine = (j == x) ? c : mine; }
        if (sum == G) break;
        __builtin_amdgcn_s_sleep(1);
        if ((++sp & 255u) == 0u) { if (xb_ld(&bar[XB_TMO])) break; if (sp > XB_SPIN_CAP) { atomicAdd(&bar[XB_TMO], 1u); break; } }
    }
    nloc = mine > 0u ? mine : 1u; nx = cnt > 0u ? cnt : 1u;
}
__device__ __forceinline__ void xcd_barrier(const XcdBarrier& b, const int wv) {
    asm volatile("s_waitcnt vmcnt(0)" ::: "memory");
    __syncthreads();
    if (tid_of(wv) == 0) {
        unsigned* bar = b.bar;
        __builtin_amdgcn_s_waitcnt(0);
        unsigned nloc = b.st[0], nx = b.st[1];
        if (nloc == 0u) { xcd_barrier_complete(bar, b.x, nloc, nx); b.st[0] = nloc; b.st[1] = nx; }
        const unsigned old = xb_add(&bar[XB_XSUB(b.x)], 1u);
        const unsigned gen = old / nloc;
        if (old + 1u == (gen + 1u) * nloc) {
            __builtin_amdgcn_fence(__ATOMIC_RELEASE, "agent");
            asm volatile("s_waitcnt vmcnt(0)" ::: "memory");
            const unsigned og = xb_add(&bar[XB_TOP], 1u);
            const unsigned tg = og / nx;
            if (og + 1u == (tg + 1u) * nx) xb_add(&bar[XB_TOPGEN], 1u);
            else XB_SPIN(xb_ld(&bar[XB_TOPGEN]) == tg, bar);
            __builtin_amdgcn_fence(__ATOMIC_ACQUIRE, "agent");
            xb_add(&bar[XB_XGEN(b.x)], 1u);
            asm volatile("s_waitcnt vmcnt(0)" ::: "memory");
        } else {
            XB_SPIN(xb_ld(&bar[XB_XGEN(b.x)]) == gen, bar);
            __builtin_amdgcn_fence(__ATOMIC_ACQUIRE, "agent");
            asm volatile("s_waitcnt vmcnt(0)" ::: "memory");
        }
    }
    __syncthreads();
}

constexpr int A_TILE_B = 256 * 64 * 2, B_TILE_B = 64 * 256 * 2, STAGE_B = A_TILE_B + B_TILE_B;
__device__ __forceinline__ u32x4 mk_rsrc4(const void* p) { const unsigned long long a = (unsigned long long)p; u32x4 r; r.x = (unsigned)a; r.y = (unsigned)(a >> 32) & 0xffffu; r.z = 0x7fffffffu; r.w = 0x00020000u; return r; }
__device__ __forceinline__ void dma16(const u32x4 rsrc, const unsigned lds_addr, const int voff, const int soff) {
    unsigned keep;
    asm volatile("s_nop 4\n\ts_mov_b32 %0, m0\n\ts_mov_b32 m0, %1\n\ts_nop 0\n\tbuffer_load_dwordx4 %2, %3, %4 offen lds\n\ts_mov_b32 m0, %0"
                 : "=&s"(keep) : "s"(lds_addr), "v"(voff), "s"(rsrc), "s"(soff) : "memory");
}
__device__ __forceinline__ void gemm_kloop_img(const int tid, const u32x4 ra, const int abyte, const u32x4 rb, const int bbyte, const int nt,
                                               char* smem, f32x4 (&acc)[8][4]) {
    const int wid = tid >> 6, lane = tid & 63, wr = wid >> 2, wc = wid & 3, fr = lane & 15, fq = lane >> 4;
    const int a_ro = wr * 8192 + fr * 64 + ((fq ^ ((0 - (fr >> 2)) & 3)) * 16);
    const int q = fr >> 2, pq = fr & 3, gq = q | ((fq & 1) << 2);
    int b_ro[2];
#pragma unroll
    for (int n = 0; n < 2; ++n) b_ro[n] = 16384 + (8 * fq + q) * 512 + (((wc * 2 + n) ^ gq) * 32) + pq * 8;
    const int wid_u = __builtin_amdgcn_readfirstlane(wid);
    const unsigned lbase = (unsigned)(size_t)((LAS char*)smem) + wid_u * 1024;
    const int vo = tid * 16;
#define I_DMA(kt) do { const unsigned st_ = lbase + ((kt) & 3) * 32768; _Pragma("unroll") for (int i = 0; i < 2; ++i) {                        \
        dma16(ra, st_ + i * 8192, vo, abyte + (kt) * 16384 + i * 8192);                                                                        \
        dma16(rb, st_ + 16384 + i * 8192, vo, bbyte + (kt) * 16384 + i * 8192); } } while (0)
#define I_COMPUTE(kt) do { const char* base_ = smem + ((kt) & 3) * 32768; bf16x8 At[8], Bf[4];                                                 \
            _Pragma("unroll") for (int n = 0; n < 4; ++n) {                                                                                    \
                const s16x4 lo = __builtin_amdgcn_ds_read_tr16_b64_v4i16((LAS s16x4*)(base_ + b_ro[n & 1] + (n >> 1) * 256));                 \
                const s16x4 hi = __builtin_amdgcn_ds_read_tr16_b64_v4i16((LAS s16x4*)(base_ + b_ro[n & 1] + (n >> 1) * 256 + 2048));          \
                Bf[n] = (bf16x8){lo[0], lo[1], lo[2], lo[3], hi[0], hi[1], hi[2], hi[3]}; }                                                    \
            _Pragma("unroll") for (int m = 0; m < 8; ++m) At[m] = *(const bf16x8*)(base_ + a_ro + m * 1024);                                   \
            __builtin_amdgcn_sched_barrier(0);         \
            _Pragma("unroll") for (int m = 0; m < 8; ++m) _Pragma("unroll") for (int n = 0; n < 4; ++n)                                        \
                acc[m][n] = __builtin_amdgcn_mfma_f32_16x16x32_bf16(Bf[n], At[m], acc[m][n], 0, 0, 0); } while (0)
#define I_READ(kt, At_, Bf_) do { const char* base_ = smem + ((kt) & 3) * 32768;                                                               \
            _Pragma("unroll") for (int n = 0; n < 4; ++n) {                                                                                    \
                const s16x4 lo = __builtin_amdgcn_ds_read_tr16_b64_v4i16((LAS s16x4*)(base_ + b_ro[n & 1] + (n >> 1) * 256));                 \
                const s16x4 hi = __builtin_amdgcn_ds_read_tr16_b64_v4i16((LAS s16x4*)(base_ + b_ro[n & 1] + (n >> 1) * 256 + 2048));          \
                Bf_[n] = (bf16x8){lo[0], lo[1], lo[2], lo[3], hi[0], hi[1], hi[2], hi[3]}; }                                                   \
            _Pragma("unroll") for (int m = 0; m < 8; ++m) At_[m] = *(const bf16x8*)(base_ + a_ro + m * 1024); } while (0)
#define I_MMA(At_, Bf_) do { _Pragma("unroll") for (int m = 0; m < 8; ++m) _Pragma("unroll") for (int n = 0; n < 4; ++n)                       \
                acc[m][n] = __builtin_amdgcn_mfma_f32_16x16x32_bf16(Bf_[n], At_[m], acc[m][n], 0, 0, 0); } while (0)
#define I_BAR() do { asm volatile("s_waitcnt lgkmcnt(0)" ::: "memory"); __builtin_amdgcn_s_barrier(); } while (0)
    I_DMA(0); I_DMA(1); I_DMA(2); I_DMA(3);
    asm volatile("s_waitcnt vmcnt(8)" ::: "memory"); I_BAR();
    for (int t = 0; t < nt; t += 2) {
        { bf16x8 A0[8], B0[4], A1[8], B1[4];
          I_READ(t, A0, B0);
          __builtin_amdgcn_sched_barrier(0);
          I_READ(t + 1, A1, B1);
          I_MMA(A0, B0);
          __builtin_amdgcn_sched_barrier(0);
          I_MMA(A1, B1); }
        asm volatile("s_waitcnt vmcnt(0)" ::: "memory");
        I_BAR();
        if (t + 4 < nt) { I_DMA(t + 4); I_DMA(t + 5); }
    }
#undef I_DMA
#undef I_COMPUTE
#undef I_READ
#undef I_MMA
#undef I_BAR
}

__device__ __forceinline__ void stage_rc(int tid, int& R0, int& C0) { const int w = tid >> 6, l = tid & 63; R0 = 8 * w + (l >> 3); C0 = 8 * ((l & 7) ^ ((R0 >> 1) & 7)); }

__device__ __forceinline__ int a_img(int r, int k) { return r * 64 + (((k >> 3) ^ ((0 - (r >> 2)) & 3)) * 16) + (k & 7) * 2; }
__device__ __forceinline__ int b_img(int kk, int gc) {
    const int h = gc >> 6, r = gc & 63, c = (r < 32) ? h * 32 + r : 128 + h * 32 + (r - 32);
    const int g = (kk & 3) | (((kk >> 3) & 1) << 2);
    return kk * 512 + (((c >> 4) ^ g) * 32) + (c & 15) * 2;
}
__device__ __forceinline__ int opq(int v) { asm volatile("" : "+v"(v)); return v; }
__device__ __forceinline__ int tid_of(int wv) { return wv * 64 + (int)__builtin_amdgcn_mbcnt_hi(~0u, __builtin_amdgcn_mbcnt_lo(~0u, 0u)); }
__device__ __forceinline__ __amdgpu_buffer_rsrc_t mk_rsrc(const void* p) { return __builtin_amdgcn_make_buffer_rsrc((void*)p, 0, 0x7fffffff, 0x00020000); }

typedef int i32x8 __attribute__((ext_vector_type(8)));
typedef float f32x16 __attribute__((ext_vector_type(16)));
constexpr int STAGE8 = 32768, A8_B = 16384;
constexpr float YSCALE = 16.0f, YINV = 1.0f / 16.0f;
constexpr float WSCALE = 64.0f, WINV = 1.0f / 64.0f;
__device__ __forceinline__ unsigned pk8(float a, float b, float c, float d) {
    int p_ = __builtin_amdgcn_cvt_pk_fp8_f32(a, b, 0, false); p_ = __builtin_amdgcn_cvt_pk_fp8_f32(c, d, p_, true); return (unsigned)p_; }
__device__ __forceinline__ void stage_rc8(int tid, int& R0, int& C0) { const int w = tid >> 6, l = tid & 63; R0 = 16 * w + (l >> 2); C0 = 16 * ((l & 3) ^ ((R0 >> 2) & 3)); }
__device__ __forceinline__ void moe_rb(const Params& p, const int tid, const int half, const bool down, const int e, const int nt, __amdgpu_buffer_rsrc_t& rb, int& bvo, int& ldb4) {
    const float* wp = down ? p.w_down : (half ? p.w_up : p.w_gate);
    rb = mk_rsrc(wp + (size_t)e * D * FF);
    ldb4 = down ? D * 4 : FF * 4;
    const int cgu = nt * 128 + (tid & 31) * 4, cdn = nt * 256 + ((tid & 31) >> 3) * 64 + (tid >> 8) * 32 + (tid & 7) * 4;
    bvo = ((tid & 255) >> 5) * 8 * ldb4 + (down ? cdn : cgu) * 4;
}
__device__ __forceinline__ int b8_wo(const int tid) {
    const int kq = (tid & 255) >> 5, l32 = tid & 31;
    const int cc0 = (tid >> 8) * 128 + (l32 >> 3) * 32 + 8 * (l32 & 3) + 4 * ((l32 >> 2) & 1), sc = (2 * (l32 & 1) + ((l32 >> 2) & 1)) & 3;
    return A8_B + cc0 * 64 + (((kq >> 1) ^ sc) * 16) + (kq & 1) * 8;
}
#define B8_WRITE(base_, wo_) do { f32x4 v_[8]; _Pragma("unroll") for (int i = 0; i < 8; ++i) v_[i] = __builtin_bit_cast(f32x4, sb[i >> 1][i & 1]) * WSCALE;            \
        _Pragma("unroll") for (int c = 0; c < 4; ++c) { u32x2 w_; w_.x = pk8(v_[0][c], v_[1][c], v_[2][c], v_[3][c]); w_.y = pk8(v_[4][c], v_[5][c], v_[6][c], v_[7][c]);   \
            *(u32x2*)((base_) + (wo_) + c * 64) = w_; } } while (0)

template <bool AGATHER>
__device__ __forceinline__ void gemm_kloop(const int tid, const u32x4 ra, const int avo0, const int astep, const int4 avg, __amdgpu_buffer_rsrc_t rb, const int bvo, const int ldb4, const int nt,
                                           char* smem, u32x4 (&sb)[4][2], f32x16 (&acc)[4][2], const Params& p, const int wv, const bool down2, const int e2, const int nt2) {
    const int wid = tid >> 6, lane = tid & 63, wr = wid >> 2, wc = wid & 3, j = lane & 31, hl = lane >> 5;
    const int b_wo = b8_wo(tid);
    const int sw = (j >> 2) & 3, ch0 = ((2 * hl) ^ sw) * 16, ch1 = ((2 * hl + 1) ^ sw) * 16;
    const int a_ro = (wr * 128 + j) * 64, b_ro = A8_B + (wc * 32 + j) * 64;
    const int wid_u = __builtin_amdgcn_readfirstlane(wid);
    const unsigned lbase = (unsigned)(size_t)((LAS char*)smem) + wid_u * 1024;
#define A_DMA(buf, kt) do { if (AGATHER) {                                                                                                     \
            dma16(ra, lbase + (buf) * STAGE8, avg.x, (kt) * 64);                                                                               \
            dma16(ra, lbase + (buf) * STAGE8 + 8192, avg.y, (kt) * 64);                                                                        \
        } else { _Pragma("unroll") for (int i = 0; i < 2; ++i)                                                                                 \
            dma16(ra, lbase + (buf) * STAGE8 + i * 8192, avo0, (kt) * 64 + i * astep); } } while (0)
#define G_ISSUE(kt) do { _Pragma("unroll") for (int i = 0; i < 8; ++i)                                                                        \
            sb[i >> 1][i & 1] = __builtin_amdgcn_raw_buffer_load_b128(rb, bvo, ((kt) * 64 + i) * ldb4, 0); } while (0)
#define G_ISSUE2() do { __amdgpu_buffer_rsrc_t rb2; int bvo2, ldb42; moe_rb(p, opq(tid_of(wv)), wv >> 2, down2, e2, nt2, rb2, bvo2, ldb42);          \
        _Pragma("unroll") for (int i = 0; i < 8; ++i) sb[i >> 1][i & 1] = __builtin_amdgcn_raw_buffer_load_b128(rb2, bvo2, i * ldb42, 0); } while (0)
#define G_WRITE(buf, kt) B8_WRITE(smem + (buf) * STAGE8, b_wo)
#define G_COMPUTE(buf) do { const char* base_ = smem + (buf) * STAGE8; i32x8 Af[4], Bf[2];                                                  \
            _Pragma("unroll") for (int n = 0; n < 2; ++n) { const u32x4 lo = *(const u32x4*)(base_ + b_ro + n * 8192 + ch0), hi = *(const u32x4*)(base_ + b_ro + n * 8192 + ch1);   \
                Bf[n] = (i32x8){(int)lo.x, (int)lo.y, (int)lo.z, (int)lo.w, (int)hi.x, (int)hi.y, (int)hi.z, (int)hi.w}; }                     \
            _Pragma("unroll") for (int m = 0; m < 4; ++m) { const u32x4 lo = *(const u32x4*)(base_ + a_ro + m * 2048 + ch0), hi = *(const u32x4*)(base_ + a_ro + m * 2048 + ch1);   \
                Af[m] = (i32x8){(int)lo.x, (int)lo.y, (int)lo.z, (int)lo.w, (int)hi.x, (int)hi.y, (int)hi.z, (int)hi.w}; }                     \
            _Pragma("unroll") for (int m = 0; m < 4; ++m) _Pragma("unroll") for (int n = 0; n < 2; ++n)                                        \
                acc[m][n] = __builtin_amdgcn_mfma_scale_f32_32x32x64_f8f6f4(Bf[n], Af[m], acc[m][n], 0, 0, 0, 0, 0, 0); } while (0)
#define G_SYNC(more) do { if (more) asm volatile("s_waitcnt vmcnt(8)" ::: "memory"); else asm volatile("s_waitcnt vmcnt(0)" ::: "memory");     \
        asm volatile("s_waitcnt lgkmcnt(0)" ::: "memory"); __builtin_amdgcn_s_barrier(); } while (0)

    G_SYNC(false);
    for (int t = 0; t < nt - 2; ++t) {
        const int cur = t & 1;
        G_WRITE(cur ^ 1, t + 1); A_DMA(cur ^ 1, t + 1);
        G_ISSUE(t + 2);
        G_COMPUTE(cur);
        G_SYNC(true);
    }
    {
        G_WRITE(1, nt - 1); A_DMA(1, nt - 1);
        G_ISSUE2();
        G_COMPUTE(0);
        G_SYNC(true);
    }
    {
        G_COMPUTE(1);
        G_SYNC(true);
    }
#undef G_COMPUTE
#undef G_SYNC
#undef A_DMA
#undef G_ISSUE
#undef G_ISSUE2
#undef G_WRITE
}
__device__ __forceinline__ void moe_load_b(__amdgpu_buffer_rsrc_t rb, const int bvo, const int ldb4, const int kt, u32x4 (&sb)[4][2]) {
#pragma unroll
    for (int i = 0; i < 8; ++i) sb[i >> 1][i & 1] = __builtin_amdgcn_raw_buffer_load_b128(rb, bvo, (kt * 64 + i) * ldb4, 0);
}
__device__ __forceinline__ void moe_write0(const int tid, char* smem, u32x4 (&sb)[4][2]) {
    const int b_wo = b8_wo(tid);
    B8_WRITE(smem, b_wo);
}
template <bool AGATHER>
__device__ __forceinline__ void moe_dma_a0(const int tid, const u32x4 ra, const int avo0, const int astep, const int4 avg, char* smem) {
    const int wid_u = __builtin_amdgcn_readfirstlane(tid >> 6);
    const unsigned lbase = (unsigned)(size_t)((LAS char*)smem) + wid_u * 1024;
    if (AGATHER) { dma16(ra, lbase, avg.x, 0); dma16(ra, lbase + 8192, avg.y, 0); }
    else {
#pragma unroll
        for (int i = 0; i < 2; ++i) dma16(ra, lbase + i * 8192, avo0, i * astep); }
}

__device__ void phase0(const Params& p, char* smem, const int wv) {
    const int tid = opq(tid_of(wv)), wid = tid >> 6, lane = tid & 63;
    constexpr int XSB = 4096 + 16;
    char* xnm = smem;
    float* red = (float*)(smem + 16 * XSB + 256);
    for (int cb = blockIdx.x; cb < 256; cb += gridDim.x) {
        const int sec = cb >> 6, c16 = cb & 63;
        const int srccol = (sec == 0 ? 1024 : sec == 1 ? 2048 : sec == 2 ? 4096 : 5120) + c16 * 16;
        const int n = lane & 15, kq = lane >> 4;
        float wq[64];
        {
            const __amdgpu_buffer_rsrc_t rw = mk_rsrc(p.w_in);
            const int vo = (kq * 8 * PROJ + srccol + n) * 4;
            const int wid_s = __builtin_amdgcn_readfirstlane(wid);
#pragma unroll
            for (int s = 0; s < 8; ++s)
#pragma unroll
                for (int j = 0; j < 8; ++j) wq[s * 8 + j] = __builtin_bit_cast(float, __builtin_amdgcn_raw_buffer_load_b32(rw, vo, (wid_s * 256 + s * 32 + j) * PROJ * 4, 0));
        }
        __syncthreads();
#pragma unroll
        for (int rr = 0; rr < 2; ++rr) {
            const int row = wid * 2 + rr;
            const f32x4* xr = (const f32x4*)(p.meta + (size_t)row * D);
            f32x4 v[8]; float ss = 0.f;
#pragma unroll
            for (int i = 0; i < 8; ++i) { v[i] = xr[lane + 64 * i]; ss += v[i][0] * v[i][0] + v[i][1] * v[i][1] + v[i][2] * v[i][2] + v[i][3] * v[i][3]; }
            ss = wave_sum(ss);
            const float r = rsqrtf(ss * (1.0f / D) + EPS);
#pragma unroll
            for (int i = 0; i < 8; ++i) { const f32x4 w = ((const f32x4*)p.mix_w)[lane + 64 * i];
                u32x2 o; o.x = pk_bf16(v[i][0] * r * w[0], v[i][1] * r * w[1]); o.y = pk_bf16(v[i][2] * r * w[2], v[i][3] * r * w[3]);
                *(u32x2*)(xnm + row * XSB + 8 * (lane + 64 * i)) = o; }
        }
        __syncthreads();
        f32x4 am = {0.f, 0.f, 0.f, 0.f};
#pragma unroll
        for (int s = 0; s < 8; ++s) {
            const bf16x8 af = *(const bf16x8*)(xnm + n * XSB + (wid * 256 + s * 32 + kq * 8) * 2);
            u32x4 bw; bw.x = pk_bf16(wq[s * 8], wq[s * 8 + 1]); bw.y = pk_bf16(wq[s * 8 + 2], wq[s * 8 + 3]); bw.z = pk_bf16(wq[s * 8 + 4], wq[s * 8 + 5]); bw.w = pk_bf16(wq[s * 8 + 6], wq[s * 8 + 7]);
            am = __builtin_amdgcn_mfma_f32_16x16x32_bf16(af, __builtin_bit_cast(bf16x8, bw), am, 0, 0, 0);
        }
#pragma unroll
        for (int j = 0; j < 4; ++j) red[(wid * 16 + 4 * kq + j) * 16 + n] = am[j];
        __syncthreads();
        if (tid < 256) { float s = 0.f;
#pragma unroll
            for (int w = 0; w < 8; ++w) s += red[w * 256 + tid];
            p.metaproj[(tid >> 4) * 4096 + sec * 1024 + c16 * 16 + (tid & 15)] = s; }
    }
    {
        f32x4 wm[8];
#pragma unroll
        for (int i = 0; i < 8; ++i) wm[i] = ((const f32x4*)p.mix_w)[lane + 64 * i];
        const int row0 = blockIdx.x * 8 + wid, rstep = gridDim.x * 8;
        f32x4 va[8], vb[8];
        if (row0 < T) {
#pragma unroll
            for (int i = 0; i < 8; ++i) va[i] = ((const f32x4*)(p.x + (size_t)row0 * D))[lane + 64 * i];
        }
#pragma unroll 1
        for (int row = row0; row < T; row += 2 * rstep) {
#pragma unroll
            for (int hh = 0; hh < 2; ++hh) {
                const int rw = row + hh * rstep;
                if (rw < T) {
                    f32x4 (&vc)[8] = hh ? vb : va;
                    f32x4 (&vn)[8] = hh ? va : vb;
                    if (rw + rstep < T) {
#pragma unroll
                        for (int i = 0; i < 8; ++i) vn[i] = ((const f32x4*)(p.x + (size_t)(rw + rstep) * D))[lane + 64 * i];
                    }
                    float ss = 0.f;
#pragma unroll
                    for (int i = 0; i < 8; ++i) ss += vc[i][0] * vc[i][0] + vc[i][1] * vc[i][1] + vc[i][2] * vc[i][2] + vc[i][3] * vc[i][3];
                    ss = wave_sum(ss);
                    const float r = rsqrtf(ss * (1.0f / D) + EPS);
#pragma unroll
                    for (int i = 0; i < 8; ++i) {
                        u32x2 o; o.x = pk_bf16(vc[i][0] * r * wm[i][0], vc[i][1] * r * wm[i][1]); o.y = pk_bf16(vc[i][2] * r * wm[i][2], vc[i][3] * r * wm[i][3]);
                        const int col = 4 * (lane + 64 * i);
                        *(u32x2*)((char*)p.xn + ((size_t)((rw >> 8) * 64 + (col >> 5)) << 14) + a_img(rw & 255, col & 31)) = o; }
                }
            }
        }
    }
    {
        const int nthr = gridDim.x * 512, t0 = blockIdx.x * 512 + tid;
        constexpr int NIN = D * (PROJ / 4), NOUT = D * (D / 4);
        const int nb_in = (NIN + 8 * nthr - 1) / (8 * nthr), nb_out = (NOUT + 8 * nthr - 1) / (8 * nthr);
        f32x4 ba[8], bb[8];
#define CV_LOAD(b_, V) do { _Pragma("unroll") for (int j = 0; j < 8; ++j) {                                                                   \
            if ((b_) < nb_in) { const int idx = (b_) * 8 * nthr + j * nthr + t0; const int k = idx / (PROJ / 4), nn = (idx - k * (PROJ / 4)) * 4;            \
                V[j] = idx < NIN ? *(const f32x4*)(p.w_in + (size_t)k * PROJ + nn) : (f32x4){0.f, 0.f, 0.f, 0.f}; }                            \
            else { const int idx = ((b_) - nb_in) * 8 * nthr + j * nthr + t0; const int k = idx / (D / 4), nn = (idx - k * (D / 4)) * 4;       \
                V[j] = idx < NOUT ? *(const f32x4*)(p.w_out + (size_t)k * D + nn) : (f32x4){0.f, 0.f, 0.f, 0.f}; } } } while (0)
#define CV_STORE(b_, V) do { _Pragma("unroll") for (int j = 0; j < 8; ++j) {                                                                  \
            u32x2 o; o.x = pk_bf16(V[j][0], V[j][1]); o.y = pk_bf16(V[j][2], V[j][3]);                                                         \
            if ((b_) < nb_in) { const int idx = (b_) * 8 * nthr + j * nthr + t0; const int k = idx / (PROJ / 4), nn = (idx - k * (PROJ / 4)) * 4;            \
                if (idx < NIN) *(u32x2*)((char*)p.wib + ((size_t)((nn >> 8) * 64 + (k >> 5)) << 14) + b_img(k & 31, nn & 255)) = o; }          \
            else { const int idx = ((b_) - nb_in) * 8 * nthr + j * nthr + t0; const int k = idx / (D / 4), nn = (idx - k * (D / 4)) * 4;       \
                if (idx < NOUT) *(u32x2*)((char*)p.wob + ((size_t)((nn >> 8) * 64 + (k >> 5)) << 14) + b_img(k & 31, nn & 255)) = o; } } } while (0)
        const int nb = nb_in + nb_out;
        CV_LOAD(0, ba);
#pragma unroll 1
        for (int b = 0; b < nb; b += 2) {
            if (b + 1 < nb) CV_LOAD(b + 1, bb);
            CV_STORE(b, ba);
            if (b + 2 < nb) CV_LOAD(b + 2, ba);
            if (b + 1 < nb) CV_STORE(b + 1, bb);
        }
#undef CV_LOAD
#undef CV_STORE
    }
    for (int idx = blockIdx.x * 512 + tid; idx < 48 * 2048; idx += gridDim.x * 512) {
        const int n = idx >> 11, k = idx & 2047;
        const float v = n < 32 ? p.w_re[k * 32 + n] : (n < 36 ? p.w_rg[k * 4 + (n - 32)] : 0.f);
        const unsigned h = pk_bf16(v, 0.f) & 0xffffu; const float hf = bf_lo(h);
        const unsigned l = pk_bf16(v - hf, 0.f) & 0xffffu;
        p.wrt[idx] = (bf16_t)h; p.wrt[48 * 2048 + idx] = (bf16_t)l;
    }
}

__device__ void phase1(const Params& p, char* smem, const int wv) {
    const int tid0 = opq(tid_of(wv));
    const int xcd = blockIdx.x & 7, slot = blockIdx.x >> 3;
    if (slot >= 32) return;
    const u32x4 ra = mk_rsrc4(p.xn), rb = mk_rsrc4(p.wib);
    for (int r = 0; r < 3; ++r) {
        const int pm = 8 * (xcd & 3) + (slot & 7), pn = 8 * r + 4 * (xcd >> 2) + (slot >> 3);
        const int tid = opq(tid0);
        f32x4 acc[8][4];
#pragma unroll
        for (int m = 0; m < 8; ++m)
#pragma unroll
            for (int n = 0; n < 4; ++n) acc[m][n] = (f32x4){0.f, 0.f, 0.f, 0.f};
        gemm_kloop_img(tid, ra, pm * 64 * 16384, rb, pn * 64 * 16384, D / 32, smem, acc);
        { const int t2 = opq(tid_of(wv)), wid2 = t2 >> 6, lane2 = t2 & 63; const int wr = wid2 >> 2, wc = wid2 & 3, fr = lane2 & 15, fq = lane2 >> 4;
        const int col0 = pn * 256 + wc * 64 + 4 * fq;
        if (pn < 8) {
            const float* nw = pn < 4 ? p.qn_w : p.kn_w;
            const float sc = pn < 4 ? 0.125f : 1.0f;
#pragma unroll
            for (int m = 0; m < 8; ++m) {
                float ss = 0.f;
#pragma unroll
                for (int n = 0; n < 4; ++n) ss += acc[m][n][0] * acc[m][n][0] + acc[m][n][1] * acc[m][n][1] + acc[m][n][2] * acc[m][n][2] + acc[m][n][3] * acc[m][n][3];
                ss += __shfl_xor(ss, 16); ss += __shfl_xor(ss, 32);
                const float rs = rsqrtf(ss * (1.0f / 64.0f) + EPS) * sc;
#pragma unroll
                for (int n = 0; n < 4; ++n) acc[m][n] = acc[m][n] * rs;
            }
#pragma unroll
            for (int n = 0; n < 4; ++n) { const f32x4 wv = *(const f32x4*)(nw + n * 16 + 4 * fq);
#pragma unroll
                for (int m = 0; m < 8; ++m) acc[m][n] *= wv; }
        }
#pragma unroll
        for (int m = 0; m < 8; ++m) {
            bf16_t* rowp = p.proj + (size_t)(pm * 256 + wr * 128 + m * 16 + fr) * PROJ + col0;
#pragma unroll
            for (int n = 0; n < 4; ++n) { u32x2 o; o.x = pk_bf16(acc[m][n][0], acc[m][n][1]); o.y = pk_bf16(acc[m][n][2], acc[m][n][3]); *(u32x2*)(rowp + n * 16) = o; }
        }
        }
    }
}

__device__ __forceinline__ int clampi(int v, int lo, int hi) { return v < lo ? lo : (v > hi ? hi : v); }

__device__ void attn_item(const Params& p, char* smem, const int item, const int wv, const bool first) {
    const int h = item & 15, pp = (item >> 4) & 15, b = item >> 8;
    const int tid = opq(tid_of(wv)), wid = tid >> 6, lane = tid & 63, G = lane >> 4, i16 = lane & 15;
    char* Ks = smem; char* Vs = smem + 73728; char* mK = smem + 147456; char* mV = mK + 2048;
    float* relb = (float*)(mV + 2048); float* mb = relb + 960;
    const int rb = clampi(2 * pp - 4, 0, 24);
    const int nrows = (rb + 9 <= 32) ? 9 : 8;
    const int r = 2 * pp + (wid >> 2), qt = wid & 3, c0 = qt * 16;
    const int tq = b * SEQ + r * 64 + c0 + i16;
    asm volatile("s_waitcnt lgkmcnt(0)" ::: "memory"); __builtin_amdgcn_s_barrier();
    bf16x8 qf[2];
    qf[0] = *(const bf16x8*)(p.proj + (size_t)tq * PROJ + h * 64 + G * 8);
    qf[1] = *(const bf16x8*)(p.proj + (size_t)tq * PROJ + h * 64 + 32 + G * 8);
    f32x4 nwv[4];
#pragma unroll
    for (int dt = 0; dt < 4; ++dt) nwv[dt] = *(const f32x4*)(p.an_w + h * 64 + dt * 16 + 4 * G);
    {
        u32x4 kv[9], vv[9];
#pragma unroll
        for (int it = 0; it < 9; ++it) { const int u = tid + it * 512; const int tl = u >> 3, c = u & 7;
            if (tl < nrows * 64) { const bf16_t* src = p.proj + (size_t)(b * SEQ + rb * 64 + tl) * PROJ + 1024 + h * 64 + c * 8;
                kv[it] = *(const u32x4*)src; vv[it] = *(const u32x4*)(src + 1024); } }
#pragma unroll
        for (int it = 0; it < 9; ++it) { const int u = tid + it * 512; const int tl = u >> 3, c = u & 7;
            if (tl < nrows * 64) { *(u32x4*)(Ks + tl * 128 + ((c ^ (tl & 7)) * 16)) = kv[it];
                *(u32x4*)(Vs + tl * 128 + (((c >> 1) ^ ((tl >> 1) & 3)) * 32) + (c & 1) * 16) = vv[it]; } }
    }
    if (first) {
    if (tid < 256) {
        const int m = tid >> 4, d4 = (tid & 15) * 4;
        const f32x4 v = *(const f32x4*)(p.metaproj + m * 4096 + h * 64 + d4);
        float ss = v[0] * v[0] + v[1] * v[1] + v[2] * v[2] + v[3] * v[3];
        ss += __shfl_xor(ss, 1); ss += __shfl_xor(ss, 2); ss += __shfl_xor(ss, 4); ss += __shfl_xor(ss, 8);
        const float rs = rsqrtf(ss * (1.0f / 64.0f) + EPS);
        const f32x4 w = *(const f32x4*)(p.kn_w + d4);
        u32x2 o; o.x = pk_bf16(v[0] * rs * w[0], v[1] * rs * w[1]); o.y = pk_bf16(v[2] * rs * w[2], v[3] * rs * w[3]);
        *(u32x2*)(mK + m * 128 + (((d4 >> 3) ^ (m & 7)) * 16) + (d4 & 4) * 2) = o;
    } else {
        const int t2 = tid - 256, m = t2 >> 4, d4 = (t2 & 15) * 4;
        const f32x4 v = *(const f32x4*)(p.metaproj + m * 4096 + 1024 + h * 64 + d4);
        u32x2 o; o.x = pk_bf16(v[0], v[1]); o.y = pk_bf16(v[2], v[3]);
        *(u32x2*)(mV + m * 128 + (((d4 >> 4) ^ ((m >> 1) & 3)) * 32) + (d4 & 15) * 2) = o;
    }
    for (int u = tid; u < 960; u += 512) { const int dr = u >> 6, dc = (u & 63) - 16; relb[u] = (dc >= 0 && dc < 31) ? p.rel_bias[h * 465 + dr * 31 + dc] : 0.f; }
    if (tid >= 480 && tid < 496) mb[tid - 480] = p.meta_bias[h * 16 + (tid - 480)];
    }
    asm volatile("s_waitcnt lgkmcnt(0)" ::: "memory"); __builtin_amdgcn_s_barrier();

    const int kc0 = qt == 0 ? 0 : (qt == 1 ? 8 : (qt == 2 ? 24 : 32));
    const int row_start = clampi(r - 4, 0, 24), lr0 = row_start - rb;
    f32x4 S[17];
    const int kbase = (lr0 * 64 + kc0 + i16) * 128;
    const int kch0 = ((G ^ (i16 & 7)) * 16), kch1 = (((G + 4) ^ (i16 & 7)) * 16);
#pragma unroll
    for (int i = 0; i < 8; ++i)
#pragma unroll
        for (int kt = 0; kt < 2; ++kt) {
            const bf16x8 k0 = *(const bf16x8*)(Ks + kbase + i * 8192 + kt * 2048 + kch0);
            const bf16x8 k1 = *(const bf16x8*)(Ks + kbase + i * 8192 + kt * 2048 + kch1);
            f32x4 s = {0.f, 0.f, 0.f, 0.f};
            s = __builtin_amdgcn_mfma_f32_16x16x32_bf16(k0, qf[0], s, 0, 0, 0);
            s = __builtin_amdgcn_mfma_f32_16x16x32_bf16(k1, qf[1], s, 0, 0, 0);
            S[i * 2 + kt] = s;
        }
    {
        const bf16x8 k0 = *(const bf16x8*)(mK + i16 * 128 + kch0);
        const bf16x8 k1 = *(const bf16x8*)(mK + i16 * 128 + kch1);
        f32x4 s = {0.f, 0.f, 0.f, 0.f};
        s = __builtin_amdgcn_mfma_f32_16x16x32_bf16(k0, qf[0], s, 0, 0, 0);
        s = __builtin_amdgcn_mfma_f32_16x16x32_bf16(k1, qf[1], s, 0, 0, 0);
        S[16] = s;
    }
    const int qc = c0 + i16, cs = clampi(qc - 8, 0, 48);
    float mx = -3.0e38f;
    {
        const float* bl = relb + (row_start - r + 7) * 64 + (kc0 + 4 * G - qc + 15 + 16);
        float bv[8][8];
#pragma unroll
        for (int i = 0; i < 8; ++i)
#pragma unroll
            for (int e8 = 0; e8 < 8; ++e8) bv[i][e8] = bl[i * 64 + (e8 >> 2) * 16 + (e8 & 3)];
        const int kcb = kc0 + 4 * G - cs;
#pragma unroll
        for (int i = 0; i < 8; ++i)
#pragma unroll
            for (int kt = 0; kt < 2; ++kt)
#pragma unroll
                for (int j = 0; j < 4; ++j) {
                    const bool valid = (unsigned)(kcb + kt * 16 + j) < 16u;
                    const float s = valid ? S[i * 2 + kt][j] + bv[i][kt * 4 + j] : -1.0e30f;
                    S[i * 2 + kt][j] = s; mx = fmaxf(mx, s);
                }
    }
#pragma unroll
    for (int j = 0; j < 4; ++j) { const float s = S[16][j] + mb[4 * G + j]; S[16][j] = s; mx = fmaxf(mx, s); }
    mx = fmaxf(mx, __shfl_xor(mx, 16)); mx = fmaxf(mx, __shfl_xor(mx, 32));
    float sum = 0.f;
    const float L2E = 1.4426950408889634f;
#pragma unroll
    for (int t = 0; t < 17; ++t)
#pragma unroll
        for (int j = 0; j < 4; ++j) { const float e = __builtin_amdgcn_exp2f((S[t][j] - mx) * L2E); S[t][j] = e; sum += e; }
    sum += __shfl_xor(sum, 16); sum += __shfl_xor(sum, 32);
    f32x4 O[4];
#pragma unroll
    for (int dt = 0; dt < 4; ++dt) O[dt] = (f32x4){0.f, 0.f, 0.f, 0.f};
    const int qv = i16 >> 2, pv = i16 & 3, fv = 2 * (G & 1) + (qv >> 1);
    const int vbase = (lr0 * 64 + kc0 + 4 * G + qv) * 128 + pv * 8;
#pragma unroll
    for (int i = 0; i < 8; ++i) {
        u32x4 pw; pw.x = pk_bf16(S[2 * i][0], S[2 * i][1]); pw.y = pk_bf16(S[2 * i][2], S[2 * i][3]);
        pw.z = pk_bf16(S[2 * i + 1][0], S[2 * i + 1][1]); pw.w = pk_bf16(S[2 * i + 1][2], S[2 * i + 1][3]);
        const bf16x8 pf = __builtin_bit_cast(bf16x8, pw);
#pragma unroll
        for (int dt = 0; dt < 4; ++dt) {
            const int off = vbase + i * 8192 + ((dt ^ fv) * 32);
            const s16x4 lo = __builtin_amdgcn_ds_read_tr16_b64_v4i16((LAS s16x4*)(Vs + off));
            const s16x4 hi = __builtin_amdgcn_ds_read_tr16_b64_v4i16((LAS s16x4*)(Vs + off + 2048));
            const bf16x8 vf = (bf16x8){lo[0], lo[1], lo[2], lo[3], hi[0], hi[1], hi[2], hi[3]};
            O[dt] = __builtin_amdgcn_mfma_f32_16x16x32_bf16(vf, pf, O[dt], 0, 0, 0);
        }
    }
    {
        u32x4 pw; pw.x = pk_bf16(S[16][0], S[16][1]); pw.y = pk_bf16(S[16][2], S[16][3]); pw.z = 0u; pw.w = 0u;
        const bf16x8 pf = __builtin_bit_cast(bf16x8, pw);
        const int mrow = 4 * G + qv;
#pragma unroll
        for (int dt = 0; dt < 4; ++dt) {
            const s16x4 lo = __builtin_amdgcn_ds_read_tr16_b64_v4i16((LAS s16x4*)(mV + mrow * 128 + ((dt ^ ((mrow >> 1) & 3)) * 32) + pv * 8));
            const bf16x8 vf = (bf16x8){lo[0], lo[1], lo[2], lo[3], 0, 0, 0, 0};
            O[dt] = __builtin_amdgcn_mfma_f32_16x16x32_bf16(vf, pf, O[dt], 0, 0, 0);
        }
    }
    const float inv = 1.0f / sum;
    float ssq = 0.f;
#pragma unroll
    for (int dt = 0; dt < 4; ++dt) { O[dt] *= inv; ssq += O[dt][0] * O[dt][0] + O[dt][1] * O[dt][1] + O[dt][2] * O[dt][2] + O[dt][3] * O[dt][3];
        O[dt] *= nwv[dt];
        u32x2 o; o.x = pk_bf16(O[dt][0], O[dt][1]); o.y = pk_bf16(O[dt][2], O[dt][3]);
        *(u32x2*)((char*)p.mixed + ((size_t)((tq >> 8) * 64 + h * 2 + (dt >> 1)) << 14) + a_img(tq & 255, (dt & 1) * 16 + 4 * G)) = o; }
    ssq += __shfl_xor(ssq, 16); ssq += __shfl_xor(ssq, 32);
    if (G == 0) p.ss[tq * SSW + h] = ssq;
}

__device__ void conv_item(const Params& p, const int item, const int wv) {
    const int tid = opq(tid_of(wv)), lane = tid & 63;
    const int chg = tid & 127, ch = chg * 8;
    f32x4 w0a = *(const f32x4*)(p.conv_w + ch), w0b = *(const f32x4*)(p.conv_w + ch + 4);
    f32x4 w1a = *(const f32x4*)(p.conv_w + 1024 + ch), w1b = *(const f32x4*)(p.conv_w + 1024 + ch + 4);
    f32x4 w2a = *(const f32x4*)(p.conv_w + 2048 + ch), w2b = *(const f32x4*)(p.conv_w + 2048 + ch + 4);
    const float w0[8] = {w0a[0], w0a[1], w0a[2], w0a[3], w0b[0], w0b[1], w0b[2], w0b[3]};
    const float w1[8] = {w1a[0], w1a[1], w1a[2], w1a[3], w1b[0], w1b[1], w1b[2], w1b[3]};
    const float w2[8] = {w2a[0], w2a[1], w2a[2], w2a[3], w2b[0], w2b[1], w2b[2], w2b[3]};
    const f32x4 cwa = *(const f32x4*)(p.cn_w + ch), cwb = *(const f32x4*)(p.cn_w + ch + 4);
    const float cw[8] = {cwa[0], cwa[1], cwa[2], cwa[3], cwb[0], cwb[1], cwb[2], cwb[3]};
    struct CL { u32x4 bv, cc, hc, cp, hp, cn, hn; };
    const u32x4 z4 = {0u, 0u, 0u, 0u};
#define CONV_LOAD(it_, L) do { const int tok_ = item * 32 + (tid >> 7) + 4 * (it_); const int s_ = tok_ & (SEQ - 1);                          \
        const bf16_t* base_ = p.proj + (size_t)tok_ * PROJ + ch;                                                                           \
        L.bv = *(const u32x4*)(base_ + 3072); L.cc = *(const u32x4*)(base_ + 4096); L.hc = *(const u32x4*)(base_ + 5120);                  \
        if (s_ > 0) { L.cp = *(const u32x4*)(base_ - PROJ + 4096); L.hp = *(const u32x4*)(base_ - PROJ + 5120); } else { L.cp = z4; L.hp = z4; }          \
        if (s_ < SEQ - 1) { L.cn = *(const u32x4*)(base_ + PROJ + 4096); L.hn = *(const u32x4*)(base_ + PROJ + 5120); } else { L.cn = z4; L.hn = z4; } } while (0)
    CL La, Lb;
    CONV_LOAD(0, La);
#pragma unroll
    for (int it = 0; it < 8; ++it) {
        CL& L = (it & 1) ? Lb : La;
        CL& Ln = (it & 1) ? La : Lb;
        if (it + 1 < 8) CONV_LOAD(it + 1, Ln);
        const int tok = item * 32 + (tid >> 7) + 4 * it;
        const int s = tok & (SEQ - 1);
        float up[8], uc[8], un[8];
#pragma unroll
        for (int j = 0; j < 4; ++j) { uc[2 * j] = bf_lo(L.cc[j]) * bf_lo(L.hc[j]); uc[2 * j + 1] = bf_hi(L.cc[j]) * bf_hi(L.hc[j]);
            up[2 * j] = bf_lo(L.cp[j]) * bf_lo(L.hp[j]); up[2 * j + 1] = bf_hi(L.cp[j]) * bf_hi(L.hp[j]);
            un[2 * j] = bf_lo(L.cn[j]) * bf_lo(L.hn[j]); un[2 * j + 1] = bf_hi(L.cn[j]) * bf_hi(L.hn[j]); }
        if (s == 0) { const float* mp = p.metaproj + 15 * 4096;
#pragma unroll
            for (int j = 0; j < 8; ++j) up[j] = mp[2048 + ch + j] * mp[3072 + ch + j]; }
        float y[8]; float ssq = 0.f;
#pragma unroll
        for (int j = 0; j < 8; ++j) { const float bj = (j & 1) ? bf_hi(L.bv[j >> 1]) : bf_lo(L.bv[j >> 1]);
            y[j] = bj * (up[j] * w0[j] + uc[j] * w1[j] + un[j] * w2[j]); ssq += y[j] * y[j]; }
#pragma unroll
        for (int j = 0; j < 8; ++j) y[j] *= cw[j];
        u32x4 o; o.x = pk_bf16(y[0], y[1]); o.y = pk_bf16(y[2], y[3]); o.z = pk_bf16(y[4], y[5]); o.w = pk_bf16(y[6], y[7]);
        *(u32x4*)((char*)p.mixed + ((size_t)((tok >> 8) * 64 + 32 + (ch >> 5)) << 14) + a_img(tok & 255, ch & 31)) = o;
        ssq = wave_sum(ssq);
        if (lane == 0) p.ss[tok * SSW + 16 + ((tid >> 6) & 1)] = ssq;
    }
#undef CONV_LOAD
}

__device__ void phase2(const Params& p, char* smem, const int wv) {
    for (int item = blockIdx.x; item < 1024; item += gridDim.x) attn_item(p, smem, item, wv, item == (int)blockIdx.x);
    for (int item = blockIdx.x; item < 256; item += gridDim.x) conv_item(p, item, wv);
}

__device__ void phase3(const Params& p, char* smem, const int wv) {
    const int tid0 = opq(tid_of(wv));
    const int xcd = blockIdx.x & 7, slot = blockIdx.x >> 3;
    if (slot >= 32) return;
    const int tid = opq(tid0);
    float* ratio = (float*)(smem + 2 * STAGE_B);
    float* rcv = ratio + 256;
    const int pm = 8 * (xcd & 3) + (slot & 7), pn = 4 * (xcd >> 2) + (slot >> 3);
    if (tid < 256) {
        const float* sp = p.ss + (size_t)(pm * 256 + tid) * SSW;
        float sa = 0.f;
#pragma unroll
        for (int j = 0; j < 16; ++j) sa += sp[j];
        const float sc = sp[16] + sp[17];
        const float ra_ = rsqrtf(sa * (1.0f / 1024.0f) + EPS), rc = rsqrtf(sc * (1.0f / 1024.0f) + EPS);
        ratio[tid] = ra_ / rc; rcv[tid] = rc;
    }
    __syncthreads();
    const u32x4 ra = mk_rsrc4(p.mixed), rb = mk_rsrc4(p.wob);
    f32x4 acc[8][4];
#pragma unroll
    for (int m = 0; m < 8; ++m)
#pragma unroll
        for (int n = 0; n < 4; ++n) acc[m][n] = (f32x4){0.f, 0.f, 0.f, 0.f};
    gemm_kloop_img(tid, ra, pm * 64 * 16384, rb, pn * 64 * 16384, D / 64, smem, acc);
    { const int t3 = opq(tid_of(wv)), wr3 = t3 >> 8, fr3 = t3 & 15;
#pragma unroll
      for (int m = 0; m < 8; ++m) { const float s_ = ratio[wr3 * 128 + m * 16 + fr3];
#pragma unroll
          for (int n = 0; n < 4; ++n) acc[m][n] *= s_; } }
    gemm_kloop_img(tid, ra, (pm * 64 + 32) * 16384, rb, (pn * 64 + 32) * 16384, D / 64, smem, acc);
        { const int t2 = opq(tid_of(wv)), wid2 = t2 >> 6, lane2 = t2 & 63; const int wr = wid2 >> 2, wc = wid2 & 3, fr = lane2 & 15, fq = lane2 >> 4;
    {
        const size_t rbase = (size_t)(pm * 256 + wr * 128 + fr) * D + pn * 256 + wc * 64 + 4 * fq;
        f32x4 xa[4], xb[4];
#pragma unroll
        for (int n = 0; n < 4; ++n) xa[n] = *(const f32x4*)(p.x + rbase + n * 16);
#pragma unroll
        for (int m = 0; m < 8; ++m) {
            f32x4 (&xc)[4] = (m & 1) ? xb : xa;
            f32x4 (&xn)[4] = (m & 1) ? xa : xb;
            if (m + 1 < 8) {
#pragma unroll
                for (int n = 0; n < 4; ++n) xn[n] = *(const f32x4*)(p.x + rbase + (size_t)(m + 1) * 16 * D + n * 16);
            }
            const float rc = rcv[wr * 128 + m * 16 + fr];
#pragma unroll
            for (int n = 0; n < 4; ++n) { const f32x4 hv = xc[n] + acc[m][n] * rc; u32x2 o; o.x = pk_bf16(hv[0], hv[1]); o.y = pk_bf16(hv[2], hv[3]);
                *(u32x2*)(p.h2b + rbase + (size_t)m * 16 * D + n * 16) = o; }
        }
    }
    }
}

__device__ void phase4(const Params& p, char* smem, const int wv) {
    const int tid = opq(tid_of(wv)), wid = tid >> 6, lane = tid & 63, G = lane >> 4, i16 = lane & 15;
    float* part = (float*)smem;
    float* pss = part + 8 * 32 * 48;
    for (int rb = blockIdx.x; rb < T / 32; rb += gridDim.x) {
        const int row0 = rb * 32;
        f32x4 acc[2][3];
#pragma unroll
        for (int mt = 0; mt < 2; ++mt)
#pragma unroll
            for (int nt = 0; nt < 3; ++nt) acc[mt][nt] = (f32x4){0.f, 0.f, 0.f, 0.f};
        float ssq[2] = {0.f, 0.f};
        const __amdgpu_buffer_rsrc_t rhw = mk_rsrc(p.hw); const int hwvo = (row0 + i16) * D + wid * 256 + G * 8;
        u32x2 hwv[8][2];
#pragma unroll
        for (int s = 0; s < 8; ++s) {
            if (s == 2 || s == 4 || s == 6) {
#pragma unroll
                for (int s2 = s - 2; s2 < s; ++s2)
#pragma unroll
                    for (int mt = 0; mt < 2; ++mt) __builtin_amdgcn_raw_buffer_store_b64(hwv[s2][mt], rhw, hwvo, mt * 16 * D + s2 * 32, 0);
                __builtin_amdgcn_sched_barrier(0);
            }
            const int k0 = wid * 256 + s * 32 + G * 8;
            const f32x4 w0 = *(const f32x4*)(p.ffn_w + k0), w1 = *(const f32x4*)(p.ffn_w + k0 + 4);
            bf16x8 bh[3], bl[3];
#pragma unroll
            for (int nt = 0; nt < 3; ++nt) { bh[nt] = *(const bf16x8*)(p.wrt + (size_t)(nt * 16 + i16) * 2048 + k0); bl[nt] = *(const bf16x8*)(p.wrt + 48 * 2048 + (size_t)(nt * 16 + i16) * 2048 + k0); }
#pragma unroll
            for (int mt = 0; mt < 2; ++mt) {
                const size_t ro = (size_t)(row0 + mt * 16 + i16) * D + k0;
                const u32x4 hb = *(const u32x4*)(p.h2b + ro);
                const f32x4 h0 = {bf_lo(hb.x), bf_hi(hb.x), bf_lo(hb.y), bf_hi(hb.y)}, h1 = {bf_lo(hb.z), bf_hi(hb.z), bf_lo(hb.w), bf_hi(hb.w)};
                ssq[mt] += h0[0] * h0[0] + h0[1] * h0[1] + h0[2] * h0[2] + h0[3] * h0[3] + h1[0] * h1[0] + h1[1] * h1[1] + h1[2] * h1[2] + h1[3] * h1[3];
                const f32x4 t0 = h0 * w0, t1 = h1 * w1;
                u32x4 hi; hi.x = pk_bf16(t0[0], t0[1]); hi.y = pk_bf16(t0[2], t0[3]); hi.z = pk_bf16(t1[0], t1[1]); hi.w = pk_bf16(t1[2], t1[3]);
                u32x4 lo; lo.x = pk_bf16(t0[0] - bf_lo(hi.x), t0[1] - bf_hi(hi.x)); lo.y = pk_bf16(t0[2] - bf_lo(hi.y), t0[3] - bf_hi(hi.y));
                lo.z = pk_bf16(t1[0] - bf_lo(hi.z), t1[1] - bf_hi(hi.z)); lo.w = pk_bf16(t1[2] - bf_lo(hi.w), t1[3] - bf_hi(hi.w));
                { u32x2 h8; h8.x = pk8(t0[0], t0[1], t0[2], t0[3]); h8.y = pk8(t1[0], t1[1], t1[2], t1[3]); hwv[s][mt] = h8; }
                const bf16x8 ah = __builtin_bit_cast(bf16x8, hi), al = __builtin_bit_cast(bf16x8, lo);
#pragma unroll
                for (int nt = 0; nt < 3; ++nt) {
                    acc[mt][nt] = __builtin_amdgcn_mfma_f32_16x16x32_bf16(ah, bh[nt], acc[mt][nt], 0, 0, 0);
                    acc[mt][nt] = __builtin_amdgcn_mfma_f32_16x16x32_bf16(al, bh[nt], acc[mt][nt], 0, 0, 0);
                    acc[mt][nt] = __builtin_amdgcn_mfma_f32_16x16x32_bf16(ah, bl[nt], acc[mt][nt], 0, 0, 0);
                }
            }
        }
#pragma unroll
        for (int s = 6; s < 8; ++s)
#pragma unroll
            for (int mt = 0; mt < 2; ++mt) __builtin_amdgcn_raw_buffer_store_b64(hwv[s][mt], rhw, hwvo, mt * 16 * D + s * 32, 0);
        __syncthreads();
#pragma unroll
        for (int mt = 0; mt < 2; ++mt) {
#pragma unroll
            for (int nt = 0; nt < 3; ++nt)
#pragma unroll
                for (int j = 0; j < 4; ++j) part[(wid * 32 + mt * 16 + 4 * G + j) * 48 + nt * 16 + i16] = acc[mt][nt][j];
            float s = ssq[mt]; s += __shfl_xor(s, 16); s += __shfl_xor(s, 32);
            if (G == 0) pss[wid * 32 + mt * 16 + i16] = s;
        }
        __syncthreads();
        if (tid < 32) {
            const int tok = row0 + tid;
            float ssum = 0.f;
#pragma unroll
            for (int w = 0; w < 8; ++w) ssum += pss[w * 32 + tid];
            const float rr = rsqrtf(ssum * (1.0f / D) + EPS);
            float lg[4];
#pragma unroll
            for (int j = 0; j < 4; ++j) { float s = 0.f;
#pragma unroll
                for (int w = 0; w < 8; ++w) s += part[(w * 32 + tid) * 48 + 32 + j];
                lg[j] = s * rr + p.b_rg[j]; }
            int g = 0; float gm = lg[0];
#pragma unroll
            for (int j = 1; j < 4; ++j) if (lg[j] > gm) { gm = lg[j]; g = j; }
            float gs = 0.f;
#pragma unroll
            for (int j = 0; j < 4; ++j) gs += __expf(lg[j] - gm);
            const float gw = 1.0f / gs;
            float le[8];
#pragma unroll
            for (int j = 0; j < 8; ++j) { float s = 0.f;
#pragma unroll
                for (int w = 0; w < 8; ++w) s += part[(w * 32 + tid) * 48 + g * 8 + j];
                le[j] = s * rr + p.b_re[g * 8 + j]; }
            int j1 = 0; float l1 = le[0];
#pragma unroll
            for (int j = 1; j < 8; ++j) if (le[j] > l1) { l1 = le[j]; j1 = j; }
            int j2 = -1; float l2 = -3.0e38f;
#pragma unroll
            for (int j = 0; j < 8; ++j) if (j != j1 && le[j] > l2) { l2 = le[j]; j2 = j; }
            const float w1 = gw / (1.0f + __expf(l2 - l1)), w2 = gw - w1;
            const int e1 = g * 8 + j1, e2 = g * 8 + j2;
            const int p1 = atomicAdd(&p.cnt[e1 * 32], 1), p2 = atomicAdd(&p.cnt[e2 * 32], 1);
            p.tok_list[e1 * T + p1] = tok; p.w_list[e1 * T + p1] = w1; p.rr_list[e1 * T + p1] = rr;
            p.tok_list[e2 * T + p2] = tok; p.w_list[e2 * T + p2] = w2; p.rr_list[e2 * T + p2] = rr;
            *(int4*)(p.asg + tok * 4) = make_int4(e1, p1, e2, p2);
        }
        __syncthreads();
    }
}

struct MoeMap { int* cnt; int* seg; int* cum; };
__device__ __forceinline__ MoeMap moe_map(const Params& p, char* smem, const int wv) {
    MoeMap mm; mm.cnt = (int*)(smem + 2 * STAGE_B); mm.seg = mm.cnt + 32; mm.cum = mm.seg + 36;
    __syncthreads();
    if (tid_of(wv) == 0) {
        int s = 0, c = 0;
        for (int e = 0; e < NE; ++e) { const int n = p.cnt[e * 32]; mm.cnt[e] = n; mm.seg[e] = s; mm.cum[e] = c; const int nt = (n + 255) >> 8; s += nt * 256; c += nt; }
        mm.seg[NE] = s; mm.cum[NE] = c;
    }
    __syncthreads();
    return mm;
}
__device__ __forceinline__ bool moe_tile(const MoeMap& mm, const int wv, int i, int& e, int& mt, int& nt) {
    const int c = mm.cum[1 + (opq(tid_of(wv)) & 31)];
    const unsigned done_mask = (unsigned)__ballot(i >= c * 8);
    if (done_mask >> 31) return false;
    const int ee = __popc(done_mask);
    const int j = i - mm.cum[ee] * 8, nm = mm.cum[ee + 1] - mm.cum[ee];
    e = ee; nt = j / nm; mt = j - nt * nm; return true;
}

template <class P_> __device__ __forceinline__ P_* opq_s(P_* q) { asm volatile("" : "+s"(q)); return q; }
__device__ __forceinline__ int4 moe_gather(const Params& p, const int tid, const int e, const int mt, const int cnt) {
    int R0, C0; stage_rc8(tid, R0, C0); int pos; int4 av = make_int4(0, 0, 0, 0);
    pos = mt * 256 + R0;       pos = pos < cnt ? pos : cnt - 1; av.x = p.tok_list[e * T + pos] * D + C0;
    pos = mt * 256 + R0 + 128; pos = pos < cnt ? pos : cnt - 1; av.y = p.tok_list[e * T + pos] * D + C0;
    return av;
}
__device__ __forceinline__ void moe_wait_done(const Params& p, const int wv, const int e, const int cnt) {
    if (tid_of(wv) == 0) {
        const int need = ((cnt + 255) >> 8) * 8;
        unsigned spins = 0;
        while (__hip_atomic_load(&p.done[e * 32], __ATOMIC_RELAXED, __HIP_MEMORY_SCOPE_AGENT) < need) { __builtin_amdgcn_s_sleep(8); if (++spins > (1u << 22)) break; }
        __builtin_amdgcn_fence(__ATOMIC_ACQUIRE, "agent");
        asm volatile("s_waitcnt vmcnt(0)" ::: "memory");
    }
    __syncthreads();
}
__device__ void phase56(const Params& p, char* smem, const int wv) {
    const int xcd = blockIdx.x & 7, slot = blockIdx.x >> 3;
    const MoeMap mm = moe_map(p, smem, wv);
    if (slot >= 32) return;
    const int half = wv >> 2;
    const int n5 = mm.cum[NE] * 8;
    u32x4 sb[4][2];
#define ra5 mk_rsrc4(opq_s(p.hw))
#define ra6 mk_rsrc4(opq_s(p.hbuf))
    int L = (((slot >> 4) * 8 + xcd) << 4) + (slot & 15);
    int e, mt, nt;
    bool down = L >= n5;
    if (!moe_tile(mm, wv, down ? L - n5 : L, e, mt, nt)) return;
    e = __builtin_amdgcn_readfirstlane(e); mt = __builtin_amdgcn_readfirstlane(mt); nt = __builtin_amdgcn_readfirstlane(nt);
    int4 av = make_int4(0, 0, 0, 0); int avo0 = 0;
    {
        const int tid = opq(tid_of(wv));
        const int cnt = __builtin_amdgcn_readfirstlane(mm.cnt[e]), seg = __builtin_amdgcn_readfirstlane(mm.seg[e]);
        __amdgpu_buffer_rsrc_t rb; int bvo, ldb4; moe_rb(p, tid, half, down, e, nt, rb, bvo, ldb4);
        moe_load_b(rb, bvo, ldb4, 0, sb);
        if (!down) av = moe_gather(p, tid, e, mt, cnt);
        else { moe_wait_done(p, wv, e, cnt); int R0, C0; stage_rc8(tid, R0, C0); avo0 = (seg + mt * 256 + R0) * FF + C0; }
        moe_write0(tid, smem, sb);
        if (!down) moe_dma_a0<true>(tid, ra5, 0, 0, av, smem); else moe_dma_a0<false>(tid, ra6, avo0, 128 * FF, av, smem);
        moe_load_b(rb, bvo, ldb4, 1, sb);
    }
    for (;;) {
        const int cnt = __builtin_amdgcn_readfirstlane(mm.cnt[e]), seg = __builtin_amdgcn_readfirstlane(mm.seg[e]);
        const int L2 = L + 256; const bool down2 = L2 >= n5;
        int e2 = 0, mt2 = 0, nt2 = 0;
        const bool more = moe_tile(mm, wv, down2 ? L2 - n5 : L2, e2, mt2, nt2);
        e2 = __builtin_amdgcn_readfirstlane(e2); mt2 = __builtin_amdgcn_readfirstlane(mt2); nt2 = __builtin_amdgcn_readfirstlane(nt2);
        const int tid = opq(tid_of(wv));
        __amdgpu_buffer_rsrc_t rb; int bvo, ldb4;
        moe_rb(p, tid, half, down, e, nt, rb, bvo, ldb4);
        f32x16 acc[4][2];
#pragma unroll
        for (int m = 0; m < 4; ++m)
#pragma unroll
            for (int n = 0; n < 2; ++n)
#pragma unroll
                for (int r = 0; r < 16; ++r) acc[m][n][r] = 0.f;
        if (!down) gemm_kloop<true>(tid, ra5, 0, 0, av, rb, bvo, ldb4, D / 64, smem, sb, acc, p, wv, more ? down2 : down, more ? e2 : e, more ? nt2 : nt);
        else gemm_kloop<false>(tid, ra6, avo0, 128 * FF, av, rb, bvo, ldb4, FF / 64, smem, sb, acc, p, wv, more ? down2 : down, more ? e2 : e, more ? nt2 : nt);
        const int t2 = opq(tid_of(wv)), wid2 = t2 >> 6, lane2 = t2 & 63; const int wr = wid2 >> 2, wc = wid2 & 3, jr = lane2 & 31, hl = lane2 >> 5;
        float ev[4];
#pragma unroll
        for (int m = 0; m < 4; ++m) { const int rl = mt * 256 + wr * 128 + m * 32 + jr;
            ev[m] = (down ? (rl < cnt ? p.w_list[e * T + rl] : 0.f) : p.rr_list[e * T + (rl < cnt ? rl : cnt - 1)]) * WINV; }
        const bool defer = more && down2 && !down;
        int4 av2 = make_int4(0, 0, 0, 0); int avo02 = 0;
        if (more) {
            const int cnt2 = __builtin_amdgcn_readfirstlane(mm.cnt[e2]), seg2 = __builtin_amdgcn_readfirstlane(mm.seg[e2]);
            if (!down2) av2 = moe_gather(p, t2, e2, mt2, cnt2);
            moe_write0(t2, smem, sb);
            if (!defer) {
                if (!down2) moe_dma_a0<true>(t2, ra5, 0, 0, av2, smem);
                else { moe_wait_done(p, wv, e2, cnt2); int R0, C0; stage_rc8(t2, R0, C0); avo02 = (seg2 + mt2 * 256 + R0) * FF + C0; moe_dma_a0<false>(t2, ra6, avo02, 128 * FF, av2, smem); }
            }
            { __amdgpu_buffer_rsrc_t rb2; int bvo2, ldb42; moe_rb(p, t2, half, down2, e2, nt2, rb2, bvo2, ldb42); moe_load_b(rb2, bvo2, ldb42, 1, sb); }
        }
        __builtin_amdgcn_sched_barrier(0);
        if (!down) {
            const __amdgpu_buffer_rsrc_t rh = mk_rsrc(opq_s(p.hbuf));
#pragma unroll
            for (int m = 0; m < 4; ++m) {
                const int rl = mt * 256 + wr * 128 + m * 32 + jr;
                const float rr = ev[m];
                const int ob = (seg + rl) * FF + nt * 128 + wc * 32 + 16 * hl;
                float hv[16];
#pragma unroll
                for (int r = 0; r < 16; ++r) { const float gte = acc[m][0][r] * rr, upv = acc[m][1][r] * rr; hv[r] = gte / (1.0f + __expf(-gte)) * upv; }
                u32x4 o; o.x = pk8(hv[0], hv[1], hv[2], hv[3]); o.y = pk8(hv[4], hv[5], hv[6], hv[7]); o.z = pk8(hv[8], hv[9], hv[10], hv[11]); o.w = pk8(hv[12], hv[13], hv[14], hv[15]);
                __builtin_amdgcn_raw_buffer_store_b128(o, rh, ob, 0, 16);
                __builtin_amdgcn_sched_barrier(0);
            }
            asm volatile("s_waitcnt vmcnt(0)" ::: "memory");
            __syncthreads();
            if (tid_of(wv) == 0) (void)__hip_atomic_fetch_add(&p.done[e * 32], 1, __ATOMIC_RELAXED, __HIP_MEMORY_SCOPE_AGENT);
        } else {
#pragma unroll
            for (int m = 0; m < 4; ++m) {
                const int rl = mt * 256 + wr * 128 + m * 32 + jr;
                const float w = ev[m] * YSCALE;
                unsigned char* rowp = (unsigned char*)p.ybuf + (size_t)(seg + rl) * D + nt * 256 + wc * 64 + 16 * hl;
#pragma unroll
                for (int n = 0; n < 2; ++n) {
                    u32x4 o;
                    o.x = pk8(acc[m][n][0] * w, acc[m][n][1] * w, acc[m][n][2] * w, acc[m][n][3] * w); o.y = pk8(acc[m][n][4] * w, acc[m][n][5] * w, acc[m][n][6] * w, acc[m][n][7] * w);
                    o.z = pk8(acc[m][n][8] * w, acc[m][n][9] * w, acc[m][n][10] * w, acc[m][n][11] * w); o.w = pk8(acc[m][n][12] * w, acc[m][n][13] * w, acc[m][n][14] * w, acc[m][n][15] * w);
                    *(u32x4*)(rowp + n * 32) = o;
                }
            }
        }
        if (!more) break;
        if (defer) {
            const int cnt2 = __builtin_amdgcn_readfirstlane(mm.cnt[e2]), seg2 = __builtin_amdgcn_readfirstlane(mm.seg[e2]);
            moe_wait_done(p, wv, e2, cnt2);
            const int t3 = opq(tid_of(wv)); int R0, C0; stage_rc8(t3, R0, C0); avo02 = (seg2 + mt2 * 256 + R0) * FF + C0;
            moe_dma_a0<false>(t3, ra6, avo02, 128 * FF, av2, smem);
        }
        L = L2; down = down2; e = e2; mt = mt2; nt = nt2; av = av2; avo0 = avo02;
    }
#undef ra5
#undef ra6
}

__device__ void phase7(const Params& p, char* smem, const int wv) {
    const int tid = opq(tid_of(wv)), wid = tid >> 6, lane = tid & 63;
    const MoeMap mm = moe_map(p, smem, wv);
    typedef float f32x2_t __attribute__((ext_vector_type(2)));
    for (int tok = blockIdx.x * 8 + wid; tok < T; tok += gridDim.x * 8) {
        const int4 a = *(const int4*)(p.asg + tok * 4);
        const unsigned char* ya = (const unsigned char*)p.ybuf + (size_t)(mm.seg[a.x] + a.y) * D;
        const unsigned char* yb = (const unsigned char*)p.ybuf + (size_t)(mm.seg[a.z] + a.w) * D;
        const bf16_t* hb = p.h2b + (size_t)tok * D;
        float* o = p.out + (size_t)tok * D;
        u32x4 h[2][2], u1[2], u2[2];
#pragma unroll
        for (int i = 0; i < 2; ++i) { const int c = 16 * (lane + 64 * i); h[i][0] = *(const u32x4*)(hb + c); h[i][1] = *(const u32x4*)(hb + c + 8);
            u1[i] = *(const u32x4*)(ya + c); u2[i] = *(const u32x4*)(yb + c); }
#pragma unroll
        for (int i = 0; i < 2; ++i) { const int c = 16 * (lane + 64 * i);
#pragma unroll
            for (int q = 0; q < 4; ++q) {
                const f32x2_t a01 = __builtin_amdgcn_cvt_pk_f32_fp8((int)u1[i][q], false), a23 = __builtin_amdgcn_cvt_pk_f32_fp8((int)u1[i][q], true);
                const f32x2_t b01 = __builtin_amdgcn_cvt_pk_f32_fp8((int)u2[i][q], false), b23 = __builtin_amdgcn_cvt_pk_f32_fp8((int)u2[i][q], true);
                const unsigned hA = h[i][q >> 1][(2 * q) & 3], hB = h[i][q >> 1][(2 * q + 1) & 3];
                f32x4 v;
                v[0] = bf_lo(hA) + (a01[0] + b01[0]) * YINV; v[1] = bf_hi(hA) + (a01[1] + b01[1]) * YINV;
                v[2] = bf_lo(hB) + (a23[0] + b23[0]) * YINV; v[3] = bf_hi(hB) + (a23[1] + b23[1]) * YINV;
                *(f32x4*)(o + c + 4 * q) = v;
            }
        }
    }
}

template <int PH> __device__ __forceinline__ void run_phase(const Params& p, char* smem, const int wv) {
    if (PH == 0) phase0(p, smem, wv); else if (PH == 1) phase1(p, smem, wv); else if (PH == 2) phase2(p, smem, wv); else if (PH == 3) phase3(p, smem, wv);
    else if (PH == 4) phase4(p, smem, wv); else if (PH == 5) phase56(p, smem, wv); else phase7(p, smem, wv);
}
#if N_LAUNCH_SPLIT
template <int PH> __global__ void __launch_bounds__(512) ph_kernel(Params p) {
    __shared__ __attribute__((aligned(1024))) char smem[SMEM_BYTES];
    run_phase<PH>(p, smem, __builtin_amdgcn_readfirstlane(threadIdx.x >> 6));
}
#else
__global__ void __launch_bounds__(512) fwd_kernel(Params p) {
    __shared__ __attribute__((aligned(1024))) char smem[SMEM_BYTES];
    volatile LAS unsigned* st = (volatile LAS unsigned*)(smem + SMEM_BYTES - 16);
    const int wv = __builtin_amdgcn_readfirstlane(threadIdx.x >> 6);
    if (tid_of(wv) == 0) { st[0] = 0u; st[1] = 0u; }
    __syncthreads();
    const XcdBarrier xb = xcd_barrier_post(p.bar, st, wv);
#ifndef PROBE_DUP
#define PROBE_DUP -1
#endif
#define RUNP(n) do { run_phase<n>(p, smem, wv); xcd_barrier(xb, wv); if (PROBE_DUP == n) { run_phase<n>(p, smem, wv); xcd_barrier(xb, wv); } } while (0)
    RUNP(0); RUNP(1); RUNP(2); RUNP(3); RUNP(4); RUNP(5);
    run_phase<7>(p, smem, wv);
}
#endif

extern "C" void kernel_launch(void* const* d_in, const int* in_sizes, int n_in, void* d_out, int out_size, void* d_ws, size_t ws_size, hipStream_t stream) {
    (void)in_sizes; (void)n_in; (void)out_size; (void)ws_size;
    Params p{};
    p.x = (const float*)d_in[0]; p.meta = (const float*)d_in[1]; p.mix_w = (const float*)d_in[2]; p.w_in = (const float*)d_in[3];
    p.qn_w = (const float*)d_in[4]; p.kn_w = (const float*)d_in[5]; p.rel_bias = (const float*)d_in[6]; p.meta_bias = (const float*)d_in[7];
    p.conv_w = (const float*)d_in[8]; p.an_w = (const float*)d_in[9]; p.cn_w = (const float*)d_in[10]; p.w_out = (const float*)d_in[11];
    p.ffn_w = (const float*)d_in[12]; p.w_rg = (const float*)d_in[13]; p.b_rg = (const float*)d_in[14]; p.w_re = (const float*)d_in[15];
    p.b_re = (const float*)d_in[16]; p.w_gate = (const float*)d_in[17]; p.w_up = (const float*)d_in[18]; p.w_down = (const float*)d_in[19];
    p.out = (float*)d_out;
    char* ws = (char*)d_ws; size_t off = 0;
    auto take = [&](size_t bytes) { char* r = ws + off; off += (bytes + 4095) & ~(size_t)4095; return r; };
    p.bar = (unsigned*)take(16384);
    p.cnt = (int*)take(8192);
    p.done = p.cnt + 1024;
    const size_t zero_bytes = off;
    p.xn = (bf16_t*)take((size_t)T * D * 2);
    p.proj = (bf16_t*)take((size_t)T * PROJ * 2);
    p.metaproj = (float*)take(16 * 4096 * 4);
    p.wrt = (bf16_t*)take(2 * 48 * 2048 * 2);
    p.wib = (bf16_t*)take((size_t)D * PROJ * 2);
    p.wob = (bf16_t*)take((size_t)D * D * 2);
    p.mixed = (bf16_t*)take((size_t)T * D * 2);
    p.ss = (float*)take((size_t)T * SSW * 4);
    p.hw = (bf16_t*)take((size_t)T * D * 2);
    p.h2b = p.xn;
    p.rr_list = (float*)take(NE * T * 4);
    p.asg = (int*)take(T * 16);
    p.tok_list = (int*)take(NE * T * 4);
    p.w_list = (float*)take(NE * T * 4);
    p.hbuf = (bf16_t*)take((size_t)HROWS * FF * 2);
    p.ybuf = (bf16_t*)take((size_t)HROWS * D * 2);
    (void)hipMemsetAsync(d_ws, 0, zero_bytes, stream);
    const int grid = 256;
#if N_LAUNCH_SPLIT
    hipLaunchKernelGGL(ph_kernel<0>, dim3(grid), dim3(512), 0, stream, p);
    hipLaunchKernelGGL(ph_kernel<1>, dim3(grid), dim3(512), 0, stream, p);
    hipLaunchKernelGGL(ph_kernel<2>, dim3(grid), dim3(512), 0, stream, p);
    hipLaunchKernelGGL(ph_kernel<3>, dim3(grid), dim3(512), 0, stream, p);
    hipLaunchKernelGGL(ph_kernel<4>, dim3(grid), dim3(512), 0, stream, p);
    hipLaunchKernelGGL(ph_kernel<5>, dim3(grid), dim3(512), 0, stream, p);
    hipLaunchKernelGGL(ph_kernel<7>, dim3(grid), dim3(512), 0, stream, p);
#else
    void* args[] = {&p};
    hipError_t e = hipLaunchCooperativeKernel((const void*)fwd_kernel, dim3(grid), dim3(512), args, 0, stream);
    if (e != hipSuccess) fprintf(stderr, "cooperative launch failed: %s\n", hipGetErrorString(e));
#endif
}
```

```cpp
#include <hip/hip_runtime.h>
#include <cstdint>
#include <cstdio>

#ifndef N_LAUNCH_SPLIT
#define N_LAUNCH_SPLIT 0
#endif

typedef unsigned short bf16_t;
typedef short bf16x8 __attribute__((ext_vector_type(8)));
typedef short s16x4 __attribute__((ext_vector_type(4)));
typedef float f32x4 __attribute__((ext_vector_type(4)));
typedef float f32x2 __attribute__((ext_vector_type(2)));
typedef unsigned u32x4 __attribute__((ext_vector_type(4)));
typedef unsigned u32x2 __attribute__((ext_vector_type(2)));
typedef __bf16 bf2_t __attribute__((ext_vector_type(2)));
#define LAS __attribute__((address_space(3)))

constexpr int T = 8192, D = 2048, PROJ = 6144, NE = 32, FF = 1024, SEQ = 2048;
constexpr float EPS = 1e-6f;
constexpr int SMEM_BYTES = 155648;
constexpr int HROWS = 24576;
constexpr int SSW = 20;

struct Params {
    const float *x, *meta, *mix_w, *w_in, *qn_w, *kn_w, *rel_bias, *meta_bias, *conv_w, *an_w, *cn_w, *w_out, *ffn_w, *w_rg, *b_rg, *w_re, *b_re, *w_gate, *w_up, *w_down;
    float* out;
    unsigned* bar;
    int* cnt;
    int* done;
    bf16_t* xn;
    bf16_t* proj;
    float* metaproj;
    bf16_t* wrt;
    bf16_t* wib;
    bf16_t* wob;
    bf16_t* mixed;
    float* ss;
    bf16_t* hw;
    bf16_t* h2b;
    float* rr_list;
    int* asg;
    int* tok_list;
    float* w_list;
    bf16_t* hbuf;
    bf16_t* ybuf;
};

__device__ __forceinline__ unsigned pk_bf16(float a, float b) { f32x2 v = {a, b}; bf2_t r = __builtin_convertvector(v, bf2_t); return __builtin_bit_cast(unsigned, r); }
__device__ __forceinline__ float bf_lo(unsigned u) { return __builtin_bit_cast(float, u << 16); }
__device__ __forceinline__ float bf_hi(unsigned u) { return __builtin_bit_cast(float, u & 0xffff0000u); }
__device__ __forceinline__ float wave_sum(float v) {
#pragma unroll
    for (int o = 32; o > 0; o >>= 1) v += __shfl_xor(v, o);
    return v;
}

__device__ __forceinline__ int tid_of(int wv);
#define XB_TMO      128
#define XB_XCNT(j)  (256  + 64 * (j))
#define XB_XSUB(j)  (1280 + 64 * (j))
#define XB_XGEN(j)  (2304 + 64 * (j))
#define XB_TOP      3328
#define XB_TOPGEN   3392
#define XCD_BAR_WORDS 3456
#define XB_SPIN_CAP (1u << 22)
__device__ __forceinline__ unsigned xb_ld(unsigned* p)              { return __hip_atomic_load(p, __ATOMIC_RELAXED, __HIP_MEMORY_SCOPE_AGENT); }
__device__ __forceinline__ unsigned xb_add(unsigned* p, unsigned v) { return __hip_atomic_fetch_add(p, v, __ATOMIC_RELAXED, __HIP_MEMORY_SCOPE_AGENT); }
__device__ __forceinline__ unsigned xb_xcc_id() { return (unsigned)__builtin_amdgcn_s_getreg((3 << 11) | 20) & 0xFu; }
#define XB_SPIN(cond, bar) do { unsigned _sp = 0; while (cond) { __builtin_amdgcn_s_sleep(1); \
    if ((++_sp & 255u) == 0u) { if (xb_ld(&(bar)[XB_TMO])) break; if (_sp > XB_SPIN_CAP) { atomicAdd(&(bar)[XB_TMO], 1u); break; } } } } while (0)
struct XcdBarrier { unsigned* bar; unsigned x; volatile LAS unsigned* st; };
__device__ __forceinline__ XcdBarrier xcd_barrier_post(unsigned* bar, volatile LAS unsigned* st, const int wv) {
    XcdBarrier b; b.bar = bar; b.x = xb_xcc_id(); b.st = st;
    if (tid_of(wv) == 0) (void)xb_add(&bar[XB_XCNT(b.x)], 1u);
    return b;
}
__device__ __forceinline__ void xcd_barrier_complete(unsigned* bar, unsigned x, unsigned& nloc, unsigned& nx) {
    const unsigned G = gridDim.x * gridDim.y * gridDim.z;
    unsigned sum, cnt, mine, sp = 0u;
    for (;;) {
        sum = 0u; cnt = 0u; mine = 0u;
#pragma unroll
        for (unsigned j = 0; j < 16; ++j) { const unsigned c = xb_ld(&bar[XB_XCNT(j)]); sum += c; cnt += (c > 0u) ? 1u : 0u; mine = (j == x) ? c : mine; }
        if (sum == G) break;
        __builtin_amdgcn_s_sleep(1);
        if ((++sp & 255u) == 0u) { if (xb_ld(&bar[XB_TMO])) break; if (sp > XB_SPIN_CAP) { atomicAdd(&bar[XB_TMO], 1u); break; } }
    }
    nloc = mine > 0u ? mine : 1u; nx = cnt > 0u ? cnt : 1u;
}
__device__ __forceinline__ void xcd_barrier(const XcdBarrier& b, const int wv) {
    asm volatile("s_waitcnt vmcnt(0)" ::: "memory");
    __syncthreads();
    if (tid_of(wv) == 0) {
        unsigned* bar = b.bar;
        __builtin_amdgcn_s_waitcnt(0);
        unsigned nloc = b.st[0], nx = b.st[1];
        if (nloc == 0u) { xcd_barrier_complete(bar, b.x, nloc, nx); b.st[0] = nloc; b.st[1] = nx; }
        const unsigned old = xb_add(&bar[XB_XSUB(b.x)], 1u);
        const unsigned gen = old / nloc;
        if (old + 1u == (gen + 1u) * nloc) {
            __builtin_amdgcn_fence(__ATOMIC_RELEASE, "agent");
            asm volatile("s_waitcnt vmcnt(0)" ::: "memory");
            const unsigned og = xb_add(&bar[XB_TOP], 1u);
            const unsigned tg = og / nx;
            if (og + 1u == (tg + 1u) * nx) xb_add(&bar[XB_TOPGEN], 1u);
            else XB_SPIN(xb_ld(&bar[XB_TOPGEN]) == tg, bar);
            __builtin_amdgcn_fence(__ATOMIC_ACQUIRE, "agent");
            xb_add(&bar[XB_XGEN(b.x)], 1u);
            asm volatile("s_waitcnt vmcnt(0)" ::: "memory");
        } else {
            XB_SPIN(xb_ld(&bar[XB_XGEN(b.x)]) == gen, bar);
            __builtin_amdgcn_fence(__ATOMIC_ACQUIRE, "agent");
            asm volatile("s_waitcnt vmcnt(0)" ::: "memory");
        }
    }
    __syncthreads();
}

constexpr int A_TILE_B = 256 * 64 * 2, B_TILE_B = 64 * 256 * 2, STAGE_B = A_TILE_B + B_TILE_B;
__device__ __forceinline__ u32x4 mk_rsrc4(const void* p) { const unsigned long long a = (unsigned long long)p; u32x4 r; r.x = (unsigned)a; r.y = (unsigned)(a >> 32) & 0xffffu; r.z = 0x7fffffffu; r.w = 0x00020000u; return r; }
__device__ __forceinline__ void dma16(const u32x4 rsrc, const unsigned lds_addr, const int voff, const int soff) {
    unsigned keep;
    asm volatile("s_nop 4\n\ts_mov_b32 %0, m0\n\ts_mov_b32 m0, %1\n\ts_nop 0\n\tbuffer_load_dwordx4 %2, %3, %4 offen lds\n\ts_mov_b32 m0, %0"
                 : "=&s"(keep) : "s"(lds_addr), "v"(voff), "s"(rsrc), "s"(soff) : "memory");
}
__device__ __forceinline__ void gemm_kloop_img(const int tid, const u32x4 ra, const int abyte, const u32x4 rb, const int bbyte, const int nt,
                                               char* smem, f32x4 (&acc)[8][4]) {
    const int wid = tid >> 6, lane = tid & 63, wr = wid >> 2, wc = wid & 3, fr = lane & 15, fq = lane >> 4;
    const int a_ro = wr * 8192 + fr * 64 + ((fq ^ ((0 - (fr >> 2)) & 3)) * 16);
    const int q = fr >> 2, pq = fr & 3, gq = q | ((fq & 1) << 2);
    int b_ro[2];
#pragma unroll
    for (int n = 0; n < 2; ++n) b_ro[n] = 16384 + (8 * fq + q) * 512 + (((wc * 2 + n) ^ gq) * 32) + pq * 8;
    const int wid_u = __builtin_amdgcn_readfirstlane(wid);
    const unsigned lbase = (unsigned)(size_t)((LAS char*)smem) + wid_u * 1024;
    const int vo = tid * 16;
#define I_DMA(kt) do { const unsigned st_ = lbase + ((kt) & 3) * 32768; _Pragma("unroll") for (int i = 0; i < 2; ++i) {                        \
        dma16(ra, st_ + i * 8192, vo, abyte + (kt) * 16384 + i * 8192);                                                                        \
        dma16(rb, st_ + 16384 + i * 8192, vo, bbyte + (kt) * 16384 + i * 8192); } } while (0)
#define I_COMPUTE(kt) do { const char* base_ = smem + ((kt) & 3) * 32768; bf16x8 At[8], Bf[4];                                                 \
            _Pragma("unroll") for (int n = 0; n < 4; ++n) {                                                                                    \
                const s16x4 lo = __builtin_amdgcn_ds_read_tr16_b64_v4i16((LAS s16x4*)(base_ + b_ro[n & 1] + (n >> 1) * 256));                 \
                const s16x4 hi = __builtin_amdgcn_ds_read_tr16_b64_v4i16((LAS s16x4*)(base_ + b_ro[n & 1] + (n >> 1) * 256 + 2048));          \
                Bf[n] = (bf16x8){lo[0], lo[1], lo[2], lo[3], hi[0], hi[1], hi[2], hi[3]}; }                                                    \
            _Pragma("unroll") for (int m = 0; m < 8; ++m) At[m] = *(const bf16x8*)(base_ + a_ro + m * 1024);                                   \
            __builtin_amdgcn_sched_barrier(0);         \
            _Pragma("unroll") for (int m = 0; m < 8; ++m) _Pragma("unroll") for (int n = 0; n < 4; ++n)                                        \
                acc[m][n] = __builtin_amdgcn_mfma_f32_16x16x32_bf16(Bf[n], At[m], acc[m][n], 0, 0, 0); } while (0)
#define I_READ(kt, At_, Bf_) do { const char* base_ = smem + ((kt) & 3) * 32768;                                                               \
            _Pragma("unroll") for (int n = 0; n < 4; ++n) {                                                                                    \
                const s16x4 lo = __builtin_amdgcn_ds_read_tr16_b64_v4i16((LAS s16x4*)(base_ + b_ro[n & 1] + (n >> 1) * 256));                 \
                const s16x4 hi = __builtin_amdgcn_ds_read_tr16_b64_v4i16((LAS s16x4*)(base_ + b_ro[n & 1] + (n >> 1) * 256 + 2048));          \
                Bf_[n] = (bf16x8){lo[0], lo[1], lo[2], lo[3], hi[0], hi[1], hi[2], hi[3]}; }                                                   \
            _Pragma("unroll") for (int m = 0; m < 8; ++m) At_[m] = *(const bf16x8*)(base_ + a_ro + m * 1024); } while (0)
#define I_MMA(At_, Bf_) do { _Pragma("unroll") for (int m = 0; m < 8; ++m) _Pragma("unroll") for (int n = 0; n < 4; ++n)                       \
                acc[m][n] = __builtin_amdgcn_mfma_f32_16x16x32_bf16(Bf_[n], At_[m], acc[m][n], 0, 0, 0); } while (0)
#define I_BAR() do { asm volatile("s_waitcnt lgkmcnt(0)" ::: "memory"); __builtin_amdgcn_s_barrier(); } while (0)
    I_DMA(0); I_DMA(1); I_DMA(2); I_DMA(3);
    asm volatile("s_waitcnt vmcnt(8)" ::: "memory"); I_BAR();
    for (int t = 0; t < nt; t += 2) {
        { bf16x8 A0[8], B0[4], A1[8], B1[4];
          I_READ(t, A0, B0);
          __builtin_amdgcn_sched_barrier(0);
          I_READ(t + 1, A1, B1);
          I_MMA(A0, B0);
          __builtin_amdgcn_sched_barrier(0);
          I_MMA(A1, B1); }
        asm volatile("s_waitcnt vmcnt(0)" ::: "memory");
        I_BAR();
        if (t + 4 < nt) { I_DMA(t + 4); I_DMA(t + 5); }
    }
#undef I_DMA
#undef I_COMPUTE
#undef I_READ
#undef I_MMA
#undef I_BAR
}

__device__ __forceinline__ void stage_rc(int tid, int& R0, int& C0) { const int w = tid >> 6, l = tid & 63; R0 = 8 * w + (l >> 3); C0 = 8 * ((l & 7) ^ ((R0 >> 1) & 7)); }

__device__ __forceinline__ int a_img(int r, int k) { return r * 64 + (((k >> 3) ^ ((0 - (r >> 2)) & 3)) * 16) + (k & 7) * 2; }
__device__ __forceinline__ int b_img(int kk, int gc) {
    const int h = gc >> 6, r = gc & 63, c = (r < 32) ? h * 32 + r : 128 + h * 32 + (r - 32);
    const int g = (kk & 3) | (((kk >> 3) & 1) << 2);
    return kk * 512 + (((c >> 4) ^ g) * 32) + (c & 15) * 2;
}
__device__ __forceinline__ int opq(int v) { asm volatile("" : "+v"(v)); return v; }
__device__ __forceinline__ int tid_of(int wv) { return wv * 64 + (int)__builtin_amdgcn_mbcnt_hi(~0u, __builtin_amdgcn_mbcnt_lo(~0u, 0u)); }
__device__ __forceinline__ __amdgpu_buffer_rsrc_t mk_rsrc(const void* p) { return __builtin_amdgcn_make_buffer_rsrc((void*)p, 0, 0x7fffffff, 0x00020000); }

typedef int i32x8 __attribute__((ext_vector_type(8)));
typedef float f32x16 __attribute__((ext_vector_type(16)));
constexpr int STAGE8 = 32768, A8_B = 16384;
constexpr int XA_OFF = 0, XA_SZ = 32768, XB_OFF = 65536, XB_SZ = 16384;
constexpr float YSCALE = 16.0f, YINV = 1.0f / 16.0f;
constexpr float WSCALE = 64.0f, WINV = 1.0f / 64.0f;
__device__ __forceinline__ unsigned pk8(float a, float b, float c, float d) {
    int p_ = __builtin_amdgcn_cvt_pk_fp8_f32(a, b, 0, false); p_ = __builtin_amdgcn_cvt_pk_fp8_f32(c, d, p_, true); return (unsigned)p_; }
__device__ __forceinline__ void stage_rc8(int tid, int& R0, int& C0) { const int w = tid >> 6, l = tid & 63; R0 = 16 * w + (l >> 2); C0 = 16 * ((l & 3) ^ ((R0 >> 2) & 3)); }
__device__ __forceinline__ void stage_rcx(int tid, int& R0, int& C0) { const int w = tid >> 6, l = tid & 63; R0 = 8 * w + (l >> 3); C0 = 16 * ((l & 7) ^ ((R0 >> 1) & 7)); }
__device__ __forceinline__ void moe_rb(const Params& p, const int tid, const int half, const bool down, const int e, const int nt, __amdgpu_buffer_rsrc_t& rb, int& bvo, int& ldb4) {
    const float* wp = down ? p.w_down : (half ? p.w_up : p.w_gate);
    rb = mk_rsrc(wp + (size_t)e * D * FF);
    ldb4 = down ? D * 4 : FF * 4;
    const int cgu = nt * 128 + (tid & 31) * 4, cdn = nt * 256 + ((tid & 31) >> 3) * 64 + (tid >> 8) * 32 + (tid & 7) * 4;
    bvo = ((tid & 255) >> 5) * 8 * ldb4 + (down ? cdn : cgu) * 4;
}
__device__ __forceinline__ int b8_wo(const int tid) {
    const int kq = (tid & 255) >> 5, l32 = tid & 31;
    const int cc0 = (tid >> 8) * 128 + (l32 >> 3) * 32 + 8 * (l32 & 3) + 4 * ((l32 >> 2) & 1), sc = (2 * (l32 & 1) + ((l32 >> 2) & 1)) & 3;
    return cc0 * 64 + (((kq >> 1) ^ sc) * 16) + (kq & 1) * 8;
}
#define B8_WRITE(base_, wo_) do { f32x4 v_[8]; _Pragma("unroll") for (int i = 0; i < 8; ++i) v_[i] = __builtin_bit_cast(f32x4, sb[i >> 1][i & 1]) * WSCALE;            \
        _Pragma("unroll") for (int c = 0; c < 4; ++c) { u32x2 w_; w_.x = pk8(v_[0][c], v_[1][c], v_[2][c], v_[3][c]); w_.y = pk8(v_[4][c], v_[5][c], v_[6][c], v_[7][c]);   \
            *(u32x2*)((base_) + (wo_) + c * 64) = w_; } } while (0)

template <bool AGATHER>
__device__ __forceinline__ void gemm_kloop(const int tid, const u32x4 ra, const int avo0, const int astep, const int4 avg, __amdgpu_buffer_rsrc_t rb, const int bvo, const int ldb4, const int nt,
                                           char* smem, u32x4 (&sb)[4][2], f32x16 (&acc)[4][2], const Params& p, const int wv, const bool down2, const int e2, const int nt2) {
    const int wid = tid >> 6, lane = tid & 63, wr = wid >> 2, wc = wid & 3, j = lane & 31, hl = lane >> 5;
    const int b_wo = b8_wo(tid);
    const int swb = (j >> 2) & 3, chb0 = ((2 * hl) ^ swb) * 16, chb1 = ((2 * hl + 1) ^ swb) * 16;
    const int swa = (j >> 1) & 7, cha0 = ((2 * hl) ^ swa) * 16, cha1 = ((2 * hl + 1) ^ swa) * 16;
    const int a_ro = (wr * 128 + j) * 128, b_ro = (wc * 32 + j) * 64;
    const int wid_u = __builtin_amdgcn_readfirstlane(wid);
    const unsigned lbase = (unsigned)(size_t)((LAS char*)smem) + wid_u * 1024;
#define A_DMA(d) do { const unsigned ad_ = lbase + XA_OFF + ((d) & 1) * XA_SZ; if (AGATHER) {                                                 \
            dma16(ra, ad_, avg.x, (d) * 128); dma16(ra, ad_ + 8192, avg.y, (d) * 128); dma16(ra, ad_ + 16384, avg.z, (d) * 128); dma16(ra, ad_ + 24576, avg.w, (d) * 128);   \
        } else { _Pragma("unroll") for (int i = 0; i < 4; ++i) dma16(ra, ad_ + i * 8192, avo0, (d) * 128 + i * astep); } } while (0)
#define G_ISSUE(kt) do { _Pragma("unroll") for (int i = 0; i < 8; ++i)                                                                        \
            sb[i >> 1][i & 1] = __builtin_amdgcn_raw_buffer_load_b128(rb, bvo, ((kt) * 64 + i) * ldb4, 0); } while (0)
#define G_ISSUE2() do { __amdgpu_buffer_rsrc_t rb2; int bvo2, ldb42; moe_rb(p, opq(tid_of(wv)), wv >> 2, down2, e2, nt2, rb2, bvo2, ldb42);          \
        _Pragma("unroll") for (int i = 0; i < 8; ++i) sb[i >> 1][i & 1] = __builtin_amdgcn_raw_buffer_load_b128(rb2, bvo2, i * ldb42, 0); } while (0)
#define G_WRITE(kt) B8_WRITE(smem + XB_OFF + ((kt) & 1) * XB_SZ, b_wo)
#define G_COMPUTE(ab_, s64_, bb_) do { const char* abase_ = smem + XA_OFF + (ab_) * XA_SZ; const char* bbase_ = smem + XB_OFF + (bb_) * XB_SZ; i32x8 Af[4], Bf[2];      \
            _Pragma("unroll") for (int n = 0; n < 2; ++n) { const u32x4 lo = *(const u32x4*)(bbase_ + b_ro + n * 8192 + chb0), hi = *(const u32x4*)(bbase_ + b_ro + n * 8192 + chb1);   \
                Bf[n] = (i32x8){(int)lo.x, (int)lo.y, (int)lo.z, (int)lo.w, (int)hi.x, (int)hi.y, (int)hi.z, (int)hi.w}; }                     \
            _Pragma("unroll") for (int m = 0; m < 4; ++m) { const u32x4 lo = *(const u32x4*)(abase_ + a_ro + m * 4096 + (cha0 ^ (s64_))), hi = *(const u32x4*)(abase_ + a_ro + m * 4096 + (cha1 ^ (s64_)));   \
                Af[m] = (i32x8){(int)lo.x, (int)lo.y, (int)lo.z, (int)lo.w, (int)hi.x, (int)hi.y, (int)hi.z, (int)hi.w}; }                     \
            _Pragma("unroll") for (int m = 0; m < 4; ++m) _Pragma("unroll") for (int n = 0; n < 2; ++n)                                        \
                acc[m][n] = __builtin_amdgcn_mfma_scale_f32_32x32x64_f8f6f4(Bf[n], Af[m], acc[m][n], 0, 0, 0, 0, 0, 0); } while (0)
#define G_SYNC(vm_) do { if ((vm_) == 8) asm volatile("s_waitcnt vmcnt(8)" ::: "memory"); else if ((vm_) == 0) asm volatile("s_waitcnt vmcnt(0)" ::: "memory");     \
        asm volatile("s_waitcnt lgkmcnt(0)" ::: "memory"); __builtin_amdgcn_s_barrier(); } while (0)

    G_SYNC(0);
    const int nd = nt >> 1;
    for (int d = 0; d < nd - 1; ++d) {
        {   const int t = 2 * d;
            G_WRITE(t + 1); A_DMA(d + 1);
            G_ISSUE(t + 2);
            G_COMPUTE(d & 1, 0, 0);
            G_SYNC(-1); }
        {   const int t = 2 * d + 1;
            G_WRITE(t + 1);
            G_ISSUE(t + 2);
            G_COMPUTE(d & 1, 64, 1);
            G_SYNC(8); }
    }
    {
        G_WRITE(nt - 1);
        G_ISSUE2();
        G_COMPUTE((nd - 1) & 1, 0, 0);
        G_SYNC(-1);
    }
    {
        G_COMPUTE((nd - 1) & 1, 64, 1);
        G_SYNC(-1);
    }
#undef G_COMPUTE
#undef G_SYNC
#undef A_DMA
#undef G_ISSUE
#undef G_ISSUE2
#undef G_WRITE
}
__device__ __forceinline__ void moe_load_b(__amdgpu_buffer_rsrc_t rb, const int bvo, const int ldb4, const int kt, u32x4 (&sb)[4][2]) {
#pragma unroll
    for (int i = 0; i < 8; ++i) sb[i >> 1][i & 1] = __builtin_amdgcn_raw_buffer_load_b128(rb, bvo, (kt * 64 + i) * ldb4, 0);
}
__device__ __forceinline__ void moe_write0(const int tid, char* smem, u32x4 (&sb)[4][2]) {
    const int b_wo = b8_wo(tid);
    B8_WRITE(smem + XB_OFF, b_wo);
}
template <bool AGATHER>
__device__ __forceinline__ void moe_dma_a0(const int tid, const u32x4 ra, const int avo0, const int astep, const int4 avg, char* smem) {
    const int wid_u = __builtin_amdgcn_readfirstlane(tid >> 6);
    const unsigned lbase = (unsigned)(size_t)((LAS char*)smem) + wid_u * 1024 + XA_OFF;
    if (AGATHER) { dma16(ra, lbase, avg.x, 0); dma16(ra, lbase + 8192, avg.y, 0); dma16(ra, lbase + 16384, avg.z, 0); dma16(ra, lbase + 24576, avg.w, 0); }
    else {
#pragma unroll
        for (int i = 0; i < 4; ++i) dma16(ra, lbase + i * 8192, avo0, i * astep); }
}

__device__ void phase0(const Params& p, char* smem, const int wv) {
    const int tid = opq(tid_of(wv)), wid = tid >> 6, lane = tid & 63;
    constexpr int XSB = 4096 + 16;
    char* xnm = smem;
    float* red = (float*)(smem + 16 * XSB + 256);
    for (int cb = blockIdx.x; cb < 256; cb += gridDim.x) {
        const int sec = cb >> 6, c16 = cb & 63;
        const int srccol = (sec == 0 ? 1024 : sec == 1 ? 2048 : sec == 2 ? 4096 : 5120) + c16 * 16;
        const int n = lane & 15, kq = lane >> 4;
        float wq[64];
        {
            const __amdgpu_buffer_rsrc_t rw = mk_rsrc(p.w_in);
            const int vo = (kq * 8 * PROJ + srccol + n) * 4;
            const int wid_s = __builtin_amdgcn_readfirstlane(wid);
#pragma unroll
            for (int s = 0; s < 8; ++s)
#pragma unroll
                for (int j = 0; j < 8; ++j) wq[s * 8 + j] = __builtin_bit_cast(float, __builtin_amdgcn_raw_buffer_load_b32(rw, vo, (wid_s * 256 + s * 32 + j) * PROJ * 4, 0));
        }
        __syncthreads();
#pragma unroll
        for (int rr = 0; rr < 2; ++rr) {
            const int row = wid * 2 + rr;
            const f32x4* xr = (const f32x4*)(p.meta + (size_t)row * D);
            f32x4 v[8]; float ss = 0.f;
#pragma unroll
            for (int i = 0; i < 8; ++i) { v[i] = xr[lane + 64 * i]; ss += v[i][0] * v[i][0] + v[i][1] * v[i][1] + v[i][2] * v[i][2] + v[i][3] * v[i][3]; }
            ss = wave_sum(ss);
            const float r = rsqrtf(ss * (1.0f / D) + EPS);
#pragma unroll
            for (int i = 0; i < 8; ++i) { const f32x4 w = ((const f32x4*)p.mix_w)[lane + 64 * i];
                u32x2 o; o.x = pk_bf16(v[i][0] * r * w[0], v[i][1] * r * w[1]); o.y = pk_bf16(v[i][2] * r * w[2], v[i][3] * r * w[3]);
                *(u32x2*)(xnm + row * XSB + 8 * (lane + 64 * i)) = o; }
        }
        __syncthreads();
        f32x4 am = {0.f, 0.f, 0.f, 0.f};
#pragma unroll
        for (int s = 0; s < 8; ++s) {
            const bf16x8 af = *(const bf16x8*)(xnm + n * XSB + (wid * 256 + s * 32 + kq * 8) * 2);
            u32x4 bw; bw.x = pk_bf16(wq[s * 8], wq[s * 8 + 1]); bw.y = pk_bf16(wq[s * 8 + 2], wq[s * 8 + 3]); bw.z = pk_bf16(wq[s * 8 + 4], wq[s * 8 + 5]); bw.w = pk_bf16(wq[s * 8 + 6], wq[s * 8 + 7]);
            am = __builtin_amdgcn_mfma_f32_16x16x32_bf16(af, __builtin_bit_cast(bf16x8, bw), am, 0, 0, 0);
        }
#pragma unroll
        for (int j = 0; j < 4; ++j) red[(wid * 16 + 4 * kq + j) * 16 + n] = am[j];
        __syncthreads();
        if (tid < 256) { float s = 0.f;
#pragma unroll
            for (int w = 0; w < 8; ++w) s += red[w * 256 + tid];
            p.metaproj[(tid >> 4) * 4096 + sec * 1024 + c16 * 16 + (tid & 15)] = s; }
    }
    {
        f32x4 wm[8];
#pragma unroll
        for (int i = 0; i < 8; ++i) wm[i] = ((const f32x4*)p.mix_w)[lane + 64 * i];
        const int row0 = blockIdx.x * 8 + wid, rstep = gridDim.x * 8;
        f32x4 va[8], vb[8];
        if (row0 < T) {
#pragma unroll
            for (int i = 0; i < 8; ++i) va[i] = ((const f32x4*)(p.x + (size_t)row0 * D))[lane + 64 * i];
        }
#pragma unroll 1
        for (int row = row0; row < T; row += 2 * rstep) {
#pragma unroll
            for (int hh = 0; hh < 2; ++hh) {
                const int rw = row + hh * rstep;
                if (rw < T) {
                    f32x4 (&vc)[8] = hh ? vb : va;
                    f32x4 (&vn)[8] = hh ? va : vb;
                    if (rw + rstep < T) {
#pragma unroll
                        for (int i = 0; i < 8; ++i) vn[i] = ((const f32x4*)(p.x + (size_t)(rw + rstep) * D))[lane + 64 * i];
                    }
                    float ss = 0.f;
#pragma unroll
                    for (int i = 0; i < 8; ++i) ss += vc[i][0] * vc[i][0] + vc[i][1] * vc[i][1] + vc[i][2] * vc[i][2] + vc[i][3] * vc[i][3];
                    ss = wave_sum(ss);
                    const float r = rsqrtf(ss * (1.0f / D) + EPS);
#pragma unroll
                    for (int i = 0; i < 8; ++i) {
                        u32x2 o; o.x = pk_bf16(vc[i][0] * r * wm[i][0], vc[i][1] * r * wm[i][1]); o.y = pk_bf16(vc[i][2] * r * wm[i][2], vc[i][3] * r * wm[i][3]);
                        const int col = 4 * (lane + 64 * i);
                        *(u32x2*)((char*)p.xn + ((size_t)((rw >> 8) * 64 + (col >> 5)) << 14) + a_img(rw & 255, col & 31)) = o; }
                }
            }
        }
    }
    {
        const int nthr = gridDim.x * 512, t0 = blockIdx.x * 512 + tid;
        constexpr int NIN = D * (PROJ / 4), NOUT = D * (D / 4);
        const int nb_in = (NIN + 8 * nthr - 1) / (8 * nthr), nb_out = (NOUT + 8 * nthr - 1) / (8 * nthr);
        f32x4 ba[8], bb[8];
#define CV_LOAD(b_, V) do { _Pragma("unroll") for (int j = 0; j < 8; ++j) {                                                                   \
            if ((b_) < nb_in) { const int idx = (b_) * 8 * nthr + j * nthr + t0; const int k = idx / (PROJ / 4), nn = (idx - k * (PROJ / 4)) * 4;            \
                V[j] = idx < NIN ? *(const f32x4*)(p.w_in + (size_t)k * PROJ + nn) : (f32x4){0.f, 0.f, 0.f, 0.f}; }                            \
            else { const int idx = ((b_) - nb_in) * 8 * nthr + j * nthr + t0; const int k = idx / (D / 4), nn = (idx - k * (D / 4)) * 4;       \
                V[j] = idx < NOUT ? *(const f32x4*)(p.w_out + (size_t)k * D + nn) : (f32x4){0.f, 0.f, 0.f, 0.f}; } } } while (0)
#define CV_STORE(b_, V) do { _Pragma("unroll") for (int j = 0; j < 8; ++j) {                                                                  \
            u32x2 o; o.x = pk_bf16(V[j][0], V[j][1]); o.y = pk_bf16(V[j][2], V[j][3]);                                                         \
            if ((b_) < nb_in) { const int idx = (b_) * 8 * nthr + j * nthr + t0; const int k = idx / (PROJ / 4), nn = (idx - k * (PROJ / 4)) * 4;            \
                if (idx < NIN) *(u32x2*)((char*)p.wib + ((size_t)((nn >> 8) * 64 + (k >> 5)) << 14) + b_img(k & 31, nn & 255)) = o; }          \
            else { const int idx = ((b_) - nb_in) * 8 * nthr + j * nthr + t0; const int k = idx / (D / 4), nn = (idx - k * (D / 4)) * 4;       \
                if (idx < NOUT) *(u32x2*)((char*)p.wob + ((size_t)((nn >> 8) * 64 + (k >> 5)) << 14) + b_img(k & 31, nn & 255)) = o; } } } while (0)
        const int nb = nb_in + nb_out;
        CV_LOAD(0, ba);
#pragma unroll 1
        for (int b = 0; b < nb; b += 2) {
            if (b + 1 < nb) CV_LOAD(b + 1, bb);
            CV_STORE(b, ba);
            if (b + 2 < nb) CV_LOAD(b + 2, ba);
            if (b + 1 < nb) CV_STORE(b + 1, bb);
        }
#undef CV_LOAD
#undef CV_STORE
    }
    for (int idx = blockIdx.x * 512 + tid; idx < 48 * 2048; idx += gridDim.x * 512) {
        const int n = idx >> 11, k = idx & 2047;
        const float v = n < 32 ? p.w_re[k * 32 + n] : (n < 36 ? p.w_rg[k * 4 + (n - 32)] : 0.f);
        const unsigned h = pk_bf16(v, 0.f) & 0xffffu; const float hf = bf_lo(h);
        const unsigned l = pk_bf16(v - hf, 0.f) & 0xffffu;
        p.wrt[idx] = (bf16_t)h; p.wrt[48 * 2048 + idx] = (bf16_t)l;
    }
}

__device__ void phase1(const Params& p, char* smem, const int wv) {
    const int tid0 = opq(tid_of(wv));
    const int xcd = blockIdx.x & 7, slot = blockIdx.x >> 3;
    if (slot >= 32) return;
    const u32x4 ra = mk_rsrc4(p.xn), rb = mk_rsrc4(p.wib);
    for (int r = 0; r < 3; ++r) {
        const int pm = 8 * (xcd & 3) + (slot & 7), pn = 8 * r + 4 * (xcd >> 2) + (slot >> 3);
        const int tid = opq(tid0);
        f32x4 acc[8][4];
#pragma unroll
        for (int m = 0; m < 8; ++m)
#pragma unroll
            for (int n = 0; n < 4; ++n) acc[m][n] = (f32x4){0.f, 0.f, 0.f, 0.f};
        gemm_kloop_img(tid, ra, pm * 64 * 16384, rb, pn * 64 * 16384, D / 32, smem, acc);
        { const int t2 = opq(tid_of(wv)), wid2 = t2 >> 6, lane2 = t2 & 63; const int wr = wid2 >> 2, wc = wid2 & 3, fr = lane2 & 15, fq = lane2 >> 4;
        const int col0 = pn * 256 + wc * 64 + 4 * fq;
        if (pn < 8) {
            const float* nw = pn < 4 ? p.qn_w : p.kn_w;
            const float sc = pn < 4 ? 0.125f : 1.0f;
#pragma unroll
            for (int m = 0; m < 8; ++m) {
                float ss = 0.f;
#pragma unroll
                for (int n = 0; n < 4; ++n) ss += acc[m][n][0] * acc[m][n][0] + acc[m][n][1] * acc[m][n][1] + acc[m][n][2] * acc[m][n][2] + acc[m][n][3] * acc[m][n][3];
                ss += __shfl_xor(ss, 16); ss += __shfl_xor(ss, 32);
                const float rs = rsqrtf(ss * (1.0f / 64.0f) + EPS) * sc;
#pragma unroll
                for (int n = 0; n < 4; ++n) acc[m][n] = acc[m][n] * rs;
            }
#pragma unroll
            for (int n = 0; n < 4; ++n) { const f32x4 wv = *(const f32x4*)(nw + n * 16 + 4 * fq);
#pragma unroll
                for (int m = 0; m < 8; ++m) acc[m][n] *= wv; }
        }
#pragma unroll
        for (int m = 0; m < 8; ++m) {
            bf16_t* rowp = p.proj + (size_t)(pm * 256 + wr * 128 + m * 16 + fr) * PROJ + col0;
#pragma unroll
            for (int n = 0; n < 4; ++n) { u32x2 o; o.x = pk_bf16(acc[m][n][0], acc[m][n][1]); o.y = pk_bf16(acc[m][n][2], acc[m][n][3]); *(u32x2*)(rowp + n * 16) = o; }
        }
        }
    }
}

__device__ __forceinline__ int clampi(int v, int lo, int hi) { return v < lo ? lo : (v > hi ? hi : v); }

__device__ void attn_item(const Params& p, char* smem, const int item, const int wv, const bool first) {
    const int h = item & 15, pp = (item >> 4) & 15, b = item >> 8;
    const int tid = opq(tid_of(wv)), wid = tid >> 6, lane = tid & 63, G = lane >> 4, i16 = lane & 15;
    char* Ks = smem; char* Vs = smem + 73728; char* mK = smem + 147456; char* mV = mK + 2048;
    float* relb = (float*)(mV + 2048); float* mb = relb + 960;
    const int rb = clampi(2 * pp - 4, 0, 24);
    const int nrows = (rb + 9 <= 32) ? 9 : 8;
    const int r = 2 * pp + (wid >> 2), qt = wid & 3, c0 = qt * 16;
    const int tq = b * SEQ + r * 64 + c0 + i16;
    asm volatile("s_waitcnt lgkmcnt(0)" ::: "memory"); __builtin_amdgcn_s_barrier();
    bf16x8 qf[2];
    qf[0] = *(const bf16x8*)(p.proj + (size_t)tq * PROJ + h * 64 + G * 8);
    qf[1] = *(const bf16x8*)(p.proj + (size_t)tq * PROJ + h * 64 + 32 + G * 8);
    f32x4 nwv[4];
#pragma unroll
    for (int dt = 0; dt < 4; ++dt) nwv[dt] = *(const f32x4*)(p.an_w + h * 64 + dt * 16 + 4 * G);
    {
        u32x4 kv[9], vv[9];
#pragma unroll
        for (int it = 0; it < 9; ++it) { const int u = tid + it * 512; const int tl = u >> 3, c = u & 7;
            if (tl < nrows * 64) { const bf16_t* src = p.proj + (size_t)(b * SEQ + rb * 64 + tl) * PROJ + 1024 + h * 64 + c * 8;
                kv[it] = *(const u32x4*)src; vv[it] = *(const u32x4*)(src + 1024); } }
#pragma unroll
        for (int it = 0; it < 9; ++it) { const int u = tid + it * 512; const int tl = u >> 3, c = u & 7;
            if (tl < nrows * 64) { *(u32x4*)(Ks + tl * 128 + ((c ^ (tl & 7)) * 16)) = kv[it];
                *(u32x4*)(Vs + tl * 128 + (((c >> 1) ^ ((tl >> 1) & 3)) * 32) + (c & 1) * 16) = vv[it]; } }
    }
    if (first) {
    if (tid < 256) {
        const int m = tid >> 4, d4 = (tid & 15) * 4;
        const f32x4 v = *(const f32x4*)(p.metaproj + m * 4096 + h * 64 + d4);
        float ss = v[0] * v[0] + v[1] * v[1] + v[2] * v[2] + v[3] * v[3];
        ss += __shfl_xor(ss, 1); ss += __shfl_xor(ss, 2); ss += __shfl_xor(ss, 4); ss += __shfl_xor(ss, 8);
        const float rs = rsqrtf(ss * (1.0f / 64.0f) + EPS);
        const f32x4 w = *(const f32x4*)(p.kn_w + d4);
        u32x2 o; o.x = pk_bf16(v[0] * rs * w[0], v[1] * rs * w[1]); o.y = pk_bf16(v[2] * rs * w[2], v[3] * rs * w[3]);
        *(u32x2*)(mK + m * 128 + (((d4 >> 3) ^ (m & 7)) * 16) + (d4 & 4) * 2) = o;
    } else {
        const int t2 = tid - 256, m = t2 >> 4, d4 = (t2 & 15) * 4;
        const f32x4 v = *(const f32x4*)(p.metaproj + m * 4096 + 1024 + h * 64 + d4);
        u32x2 o; o.x = pk_bf16(v[0], v[1]); o.y = pk_bf16(v[2], v[3]);
        *(u32x2*)(mV + m * 128 + (((d4 >> 4) ^ ((m >> 1) & 3)) * 32) + (d4 & 15) * 2) = o;
    }
    for (int u = tid; u < 960; u += 512) { const int dr = u >> 6, dc = (u & 63) - 16; relb[u] = (dc >= 0 && dc < 31) ? p.rel_bias[h * 465 + dr * 31 + dc] : 0.f; }
    if (tid >= 480 && tid < 496) mb[tid - 480] = p.meta_bias[h * 16 + (tid - 480)];
    }
    asm volatile("s_waitcnt lgkmcnt(0)" ::: "memory"); __builtin_amdgcn_s_barrier();

    const int kc0 = qt == 0 ? 0 : (qt == 1 ? 8 : (qt == 2 ? 24 : 32));
    const int row_start = clampi(r - 4, 0, 24), lr0 = row_start - rb;
    f32x4 S[17];
    const int kbase = (lr0 * 64 + kc0 + i16) * 128;
    const int kch0 = ((G ^ (i16 & 7)) * 16), kch1 = (((G + 4) ^ (i16 & 7)) * 16);
#pragma unroll
    for (int i = 0; i < 8; ++i)
#pragma unroll
        for (int kt = 0; kt < 2; ++kt) {
            const bf16x8 k0 = *(const bf16x8*)(Ks + kbase + i * 8192 + kt * 2048 + kch0);
            const bf16x8 k1 = *(const bf16x8*)(Ks + kbase + i * 8192 + kt * 2048 + kch1);
            f32x4 s = {0.f, 0.f, 0.f, 0.f};
            s = __builtin_amdgcn_mfma_f32_16x16x32_bf16(k0, qf[0], s, 0, 0, 0);
            s = __builtin_amdgcn_mfma_f32_16x16x32_bf16(k1, qf[1], s, 0, 0, 0);
            S[i * 2 + kt] = s;
        }
    {
        const bf16x8 k0 = *(const bf16x8*)(mK + i16 * 128 + kch0);
        const bf16x8 k1 = *(const bf16x8*)(mK + i16 * 128 + kch1);
        f32x4 s = {0.f, 0.f, 0.f, 0.f};
        s = __builtin_amdgcn_mfma_f32_16x16x32_bf16(k0, qf[0], s, 0, 0, 0);
        s = __builtin_amdgcn_mfma_f32_16x16x32_bf16(k1, qf[1], s, 0, 0, 0);
        S[16] = s;
    }
    const int qc = c0 + i16, cs = clampi(qc - 8, 0, 48);
    float mx = -3.0e38f;
    {
        const float* bl = relb + (row_start - r + 7) * 64 + (kc0 + 4 * G - qc + 15 + 16);
        float bv[8][8];
#pragma unroll
        for (int i = 0; i < 8; ++i)
#pragma unroll
            for (int e8 = 0; e8 < 8; ++e8) bv[i][e8] = bl[i * 64 + (e8 >> 2) * 16 + (e8 & 3)];
        const int kcb = kc0 + 4 * G - cs;
#pragma unroll
        for (int i = 0; i < 8; ++i)
#pragma unroll
            for (int kt = 0; kt < 2; ++kt)
#pragma unroll
                for (int j = 0; j < 4; ++j) {
                    const bool valid = (unsigned)(kcb + kt * 16 + j) < 16u;
                    const float s = valid ? S[i * 2 + kt][j] + bv[i][kt * 4 + j] : -1.0e30f;
                    S[i * 2 + kt][j] = s; mx = fmaxf(mx, s);
                }
    }
#pragma unroll
    for (int j = 0; j < 4; ++j) { const float s = S[16][j] + mb[4 * G + j]; S[16][j] = s; mx = fmaxf(mx, s); }
    mx = fmaxf(mx, __shfl_xor(mx, 16)); mx = fmaxf(mx, __shfl_xor(mx, 32));
    float sum = 0.f;
    const float L2E = 1.4426950408889634f;
#pragma unroll
    for (int t = 0; t < 17; ++t)
#pragma unroll
        for (int j = 0; j < 4; ++j) { const float e = __builtin_amdgcn_exp2f((S[t][j] - mx) * L2E); S[t][j] = e; sum += e; }
    sum += __shfl_xor(sum, 16); sum += __shfl_xor(sum, 32);
    f32x4 O[4];
#pragma unroll
    for (int dt = 0; dt < 4; ++dt) O[dt] = (f32x4){0.f, 0.f, 0.f, 0.f};
    const int qv = i16 >> 2, pv = i16 & 3, fv = 2 * (G & 1) + (qv >> 1);
    const int vbase = (lr0 * 64 + kc0 + 4 * G + qv) * 128 + pv * 8;
#pragma unroll
    for (int i = 0; i < 8; ++i) {
        u32x4 pw; pw.x = pk_bf16(S[2 * i][0], S[2 * i][1]); pw.y = pk_bf16(S[2 * i][2], S[2 * i][3]);
        pw.z = pk_bf16(S[2 * i + 1][0], S[2 * i + 1][1]); pw.w = pk_bf16(S[2 * i + 1][2], S[2 * i + 1][3]);
        const bf16x8 pf = __builtin_bit_cast(bf16x8, pw);
#pragma unroll
        for (int dt = 0; dt < 4; ++dt) {
            const int off = vbase + i * 8192 + ((dt ^ fv) * 32);
            const s16x4 lo = __builtin_amdgcn_ds_read_tr16_b64_v4i16((LAS s16x4*)(Vs + off));
            const s16x4 hi = __builtin_amdgcn_ds_read_tr16_b64_v4i16((LAS s16x4*)(Vs + off + 2048));
            const bf16x8 vf = (bf16x8){lo[0], lo[1], lo[2], lo[3], hi[0], hi[1], hi[2], hi[3]};
            O[dt] = __builtin_amdgcn_mfma_f32_16x16x32_bf16(vf, pf, O[dt], 0, 0, 0);
        }
    }
    {
        u32x4 pw; pw.x = pk_bf16(S[16][0], S[16][1]); pw.y = pk_bf16(S[16][2], S[16][3]); pw.z = 0u; pw.w = 0u;
        const bf16x8 pf = __builtin_bit_cast(bf16x8, pw);
        const int mrow = 4 * G + qv;
#pragma unroll
        for (int dt = 0; dt < 4; ++dt) {
            const s16x4 lo = __builtin_amdgcn_ds_read_tr16_b64_v4i16((LAS s16x4*)(mV + mrow * 128 + ((dt ^ ((mrow >> 1) & 3)) * 32) + pv * 8));
            const bf16x8 vf = (bf16x8){lo[0], lo[1], lo[2], lo[3], 0, 0, 0, 0};
            O[dt] = __builtin_amdgcn_mfma_f32_16x16x32_bf16(vf, pf, O[dt], 0, 0, 0);
        }
    }
    const float inv = 1.0f / sum;
    float ssq = 0.f;
#pragma unroll
    for (int dt = 0; dt < 4; ++dt) { O[dt] *= inv; ssq += O[dt][0] * O[dt][0] + O[dt][1] * O[dt][1] + O[dt][2] * O[dt][2] + O[dt][3] * O[dt][3];
        O[dt] *= nwv[dt];
        u32x2 o; o.x = pk_bf16(O[dt][0], O[dt][1]); o.y = pk_bf16(O[dt][2], O[dt][3]);
        *(u32x2*)((char*)p.mixed + ((size_t)((tq >> 8) * 64 + h * 2 + (dt >> 1)) << 14) + a_img(tq & 255, (dt & 1) * 16 + 4 * G)) = o; }
    ssq += __shfl_xor(ssq, 16); ssq += __shfl_xor(ssq, 32);
    if (G == 0) p.ss[tq * SSW + h] = ssq;
}

__device__ void conv_item(const Params& p, const int item, const int wv) {
    const int tid = opq(tid_of(wv)), lane = tid & 63;
    const int chg = tid & 127, ch = chg * 8;
    f32x4 w0a = *(const f32x4*)(p.conv_w + ch), w0b = *(const f32x4*)(p.conv_w + ch + 4);
    f32x4 w1a = *(const f32x4*)(p.conv_w + 1024 + ch), w1b = *(const f32x4*)(p.conv_w + 1024 + ch + 4);
    f32x4 w2a = *(const f32x4*)(p.conv_w + 2048 + ch), w2b = *(const f32x4*)(p.conv_w + 2048 + ch + 4);
    const float w0[8] = {w0a[0], w0a[1], w0a[2], w0a[3], w0b[0], w0b[1], w0b[2], w0b[3]};
    const float w1[8] = {w1a[0], w1a[1], w1a[2], w1a[3], w1b[0], w1b[1], w1b[2], w1b[3]};
    const float w2[8] = {w2a[0], w2a[1], w2a[2], w2a[3], w2b[0], w2b[1], w2b[2], w2b[3]};
    const f32x4 cwa = *(const f32x4*)(p.cn_w + ch), cwb = *(const f32x4*)(p.cn_w + ch + 4);
    const float cw[8] = {cwa[0], cwa[1], cwa[2], cwa[3], cwb[0], cwb[1], cwb[2], cwb[3]};
    struct CL { u32x4 bv, cc, hc, cp, hp, cn, hn; };
    const u32x4 z4 = {0u, 0u, 0u, 0u};
#define CONV_LOAD(it_, L) do { const int tok_ = item * 32 + (tid >> 7) + 4 * (it_); const int s_ = tok_ & (SEQ - 1);                          \
        const bf16_t* base_ = p.proj + (size_t)tok_ * PROJ + ch;                                                                           \
        L.bv = *(const u32x4*)(base_ + 3072); L.cc = *(const u32x4*)(base_ + 4096); L.hc = *(const u32x4*)(base_ + 5120);                  \
        if (s_ > 0) { L.cp = *(const u32x4*)(base_ - PROJ + 4096); L.hp = *(const u32x4*)(base_ - PROJ + 5120); } else { L.cp = z4; L.hp = z4; }          \
        if (s_ < SEQ - 1) { L.cn = *(const u32x4*)(base_ + PROJ + 4096); L.hn = *(const u32x4*)(base_ + PROJ + 5120); } else { L.cn = z4; L.hn = z4; } } while (0)
    CL La, Lb;
    CONV_LOAD(0, La);
#pragma unroll
    for (int it = 0; it < 8; ++it) {
        CL& L = (it & 1) ? Lb : La;
        CL& Ln = (it & 1) ? La : Lb;
        if (it + 1 < 8) CONV_LOAD(it + 1, Ln);
        const int tok = item * 32 + (tid >> 7) + 4 * it;
        const int s = tok & (SEQ - 1);
        float up[8], uc[8], un[8];
#pragma unroll
        for (int j = 0; j < 4; ++j) { uc[2 * j] = bf_lo(L.cc[j]) * bf_lo(L.hc[j]); uc[2 * j + 1] = bf_hi(L.cc[j]) * bf_hi(L.hc[j]);
            up[2 * j] = bf_lo(L.cp[j]) * bf_lo(L.hp[j]); up[2 * j + 1] = bf_hi(L.cp[j]) * bf_hi(L.hp[j]);
            un[2 * j] = bf_lo(L.cn[j]) * bf_lo(L.hn[j]); un[2 * j + 1] = bf_hi(L.cn[j]) * bf_hi(L.hn[j]); }
        if (s == 0) { const float* mp = p.metaproj + 15 * 4096;
#pragma unroll
            for (int j = 0; j < 8; ++j) up[j] = mp[2048 + ch + j] * mp[3072 + ch + j]; }
        float y[8]; float ssq = 0.f;
#pragma unroll
        for (int j = 0; j < 8; ++j) { const float bj = (j & 1) ? bf_hi(L.bv[j >> 1]) : bf_lo(L.bv[j >> 1]);
            y[j] = bj * (up[j] * w0[j] + uc[j] * w1[j] + un[j] * w2[j]); ssq += y[j] * y[j]; }
#pragma unroll
        for (int j = 0; j < 8; ++j) y[j] *= cw[j];
        u32x4 o; o.x = pk_bf16(y[0], y[1]); o.y = pk_bf16(y[2], y[3]); o.z = pk_bf16(y[4], y[5]); o.w = pk_bf16(y[6], y[7]);
        *(u32x4*)((char*)p.mixed + ((size_t)((tok >> 8) * 64 + 32 + (ch >> 5)) << 14) + a_img(tok & 255, ch & 31)) = o;
        ssq = wave_sum(ssq);
        if (lane == 0) p.ss[tok * SSW + 16 + ((tid >> 6) & 1)] = ssq;
    }
#undef CONV_LOAD
}

__device__ void phase2(const Params& p, char* smem, const int wv) {
    for (int item = blockIdx.x; item < 1024; item += gridDim.x) attn_item(p, smem, item, wv, item == (int)blockIdx.x);
    for (int item = blockIdx.x; item < 256; item += gridDim.x) conv_item(p, item, wv);
}

__device__ void phase3(const Params& p, char* smem, const int wv) {
    const int tid0 = opq(tid_of(wv));
    const int xcd = blockIdx.x & 7, slot = blockIdx.x >> 3;
    if (slot >= 32) return;
    const int tid = opq(tid0);
    float* ratio = (float*)(smem + 2 * STAGE_B);
    float* rcv = ratio + 256;
    const int pm = 8 * (xcd & 3) + (slot & 7), pn = 4 * (xcd >> 2) + (slot >> 3);
    if (tid < 256) {
        const float* sp = p.ss + (size_t)(pm * 256 + tid) * SSW;
        float sa = 0.f;
#pragma unroll
        for (int j = 0; j < 16; ++j) sa += sp[j];
        const float sc = sp[16] + sp[17];
        const float ra_ = rsqrtf(sa * (1.0f / 1024.0f) + EPS), rc = rsqrtf(sc * (1.0f / 1024.0f) + EPS);
        ratio[tid] = ra_ / rc; rcv[tid] = rc;
    }
    __syncthreads();
    const u32x4 ra = mk_rsrc4(p.mixed), rb = mk_rsrc4(p.wob);
    f32x4 acc[8][4];
#pragma unroll
    for (int m = 0; m < 8; ++m)
#pragma unroll
        for (int n = 0; n < 4; ++n) acc[m][n] = (f32x4){0.f, 0.f, 0.f, 0.f};
    gemm_kloop_img(tid, ra, pm * 64 * 16384, rb, pn * 64 * 16384, D / 64, smem, acc);
    { const int t3 = opq(tid_of(wv)), wr3 = t3 >> 8, fr3 = t3 & 15;
#pragma unroll
      for (int m = 0; m < 8; ++m) { const float s_ = ratio[wr3 * 128 + m * 16 + fr3];
#pragma unroll
          for (int n = 0; n < 4; ++n) acc[m][n] *= s_; } }
    gemm_kloop_img(tid, ra, (pm * 64 + 32) * 16384, rb, (pn * 64 + 32) * 16384, D / 64, smem, acc);
        { const int t2 = opq(tid_of(wv)), wid2 = t2 >> 6, lane2 = t2 & 63; const int wr = wid2 >> 2, wc = wid2 & 3, fr = lane2 & 15, fq = lane2 >> 4;
    {
        const size_t rbase = (size_t)(pm * 256 + wr * 128 + fr) * D + pn * 256 + wc * 64 + 4 * fq;
        f32x4 xa[4], xb[4];
#pragma unroll
        for (int n = 0; n < 4; ++n) xa[n] = *(const f32x4*)(p.x + rbase + n * 16);
#pragma unroll
        for (int m = 0; m < 8; ++m) {
            f32x4 (&xc)[4] = (m & 1) ? xb : xa;
            f32x4 (&xn)[4] = (m & 1) ? xa : xb;
            if (m + 1 < 8) {
#pragma unroll
                for (int n = 0; n < 4; ++n) xn[n] = *(const f32x4*)(p.x + rbase + (size_t)(m + 1) * 16 * D + n * 16);
            }
            const float rc = rcv[wr * 128 + m * 16 + fr];
#pragma unroll
            for (int n = 0; n < 4; ++n) { const f32x4 hv = xc[n] + acc[m][n] * rc; u32x2 o; o.x = pk_bf16(hv[0], hv[1]); o.y = pk_bf16(hv[2], hv[3]);
                *(u32x2*)(p.h2b + rbase + (size_t)m * 16 * D + n * 16) = o; }
        }
    }
    }
}

__device__ void phase4(const Params& p, char* smem, const int wv) {
    const int tid = opq(tid_of(wv)), wid = tid >> 6, lane = tid & 63, G = lane >> 4, i16 = lane & 15;
    float* part = (float*)smem;
    float* pss = part + 8 * 32 * 48;
    for (int rb = blockIdx.x; rb < T / 32; rb += gridDim.x) {
        const int row0 = rb * 32;
        f32x4 acc[2][3];
#pragma unroll
        for (int mt = 0; mt < 2; ++mt)
#pragma unroll
            for (int nt = 0; nt < 3; ++nt) acc[mt][nt] = (f32x4){0.f, 0.f, 0.f, 0.f};
        float ssq[2] = {0.f, 0.f};
        const __amdgpu_buffer_rsrc_t rhw = mk_rsrc(p.hw); const int hwvo = (row0 + i16) * D + wid * 256 + G * 8;
        u32x2 hwv[8][2];
#pragma unroll
        for (int s = 0; s < 8; ++s) {
            if (s == 2 || s == 4 || s == 6) {
#pragma unroll
                for (int s2 = s - 2; s2 < s; ++s2)
#pragma unroll
                    for (int mt = 0; mt < 2; ++mt) __builtin_amdgcn_raw_buffer_store_b64(hwv[s2][mt], rhw, hwvo, mt * 16 * D + s2 * 32, 0);
                __builtin_amdgcn_sched_barrier(0);
            }
            const int k0 = wid * 256 + s * 32 + G * 8;
            const f32x4 w0 = *(const f32x4*)(p.ffn_w + k0), w1 = *(const f32x4*)(p.ffn_w + k0 + 4);
            bf16x8 bh[3], bl[3];
#pragma unroll
            for (int nt = 0; nt < 3; ++nt) { bh[nt] = *(const bf16x8*)(p.wrt + (size_t)(nt * 16 + i16) * 2048 + k0); bl[nt] = *(const bf16x8*)(p.wrt + 48 * 2048 + (size_t)(nt * 16 + i16) * 2048 + k0); }
#pragma unroll
            for (int mt = 0; mt < 2; ++mt) {
                const size_t ro = (size_t)(row0 + mt * 16 + i16) * D + k0;
                const u32x4 hb = *(const u32x4*)(p.h2b + ro);
                const f32x4 h0 = {bf_lo(hb.x), bf_hi(hb.x), bf_lo(hb.y), bf_hi(hb.y)}, h1 = {bf_lo(hb.z), bf_hi(hb.z), bf_lo(hb.w), bf_hi(hb.w)};
                ssq[mt] += h0[0] * h0[0] + h0[1] * h0[1] + h0[2] * h0[2] + h0[3] * h0[3] + h1[0] * h1[0] + h1[1] * h1[1] + h1[2] * h1[2] + h1[3] * h1[3];
                const f32x4 t0 = h0 * w0, t1 = h1 * w1;
                u32x4 hi; hi.x = pk_bf16(t0[0], t0[1]); hi.y = pk_bf16(t0[2], t0[3]); hi.z = pk_bf16(t1[0], t1[1]); hi.w = pk_bf16(t1[2], t1[3]);
                u32x4 lo; lo.x = pk_bf16(t0[0] - bf_lo(hi.x), t0[1] - bf_hi(hi.x)); lo.y = pk_bf16(t0[2] - bf_lo(hi.y), t0[3] - bf_hi(hi.y));
                lo.z = pk_bf16(t1[0] - bf_lo(hi.z), t1[1] - bf_hi(hi.z)); lo.w = pk_bf16(t1[2] - bf_lo(hi.w), t1[3] - bf_hi(hi.w));
                { u32x2 h8; h8.x = pk8(t0[0], t0[1], t0[2], t0[3]); h8.y = pk8(t1[0], t1[1], t1[2], t1[3]); hwv[s][mt] = h8; }
                const bf16x8 ah = __builtin_bit_cast(bf16x8, hi), al = __builtin_bit_cast(bf16x8, lo);
#pragma unroll
                for (int nt = 0; nt < 3; ++nt) {
                    acc[mt][nt] = __builtin_amdgcn_mfma_f32_16x16x32_bf16(ah, bh[nt], acc[mt][nt], 0, 0, 0);
                    acc[mt][nt] = __builtin_amdgcn_mfma_f32_16x16x32_bf16(al, bh[nt], acc[mt][nt], 0, 0, 0);
                    acc[mt][nt] = __builtin_amdgcn_mfma_f32_16x16x32_bf16(ah, bl[nt], acc[mt][nt], 0, 0, 0);
                }
            }
        }
#pragma unroll
        for (int s = 6; s < 8; ++s)
#pragma unroll
            for (int mt = 0; mt < 2; ++mt) __builtin_amdgcn_raw_buffer_store_b64(hwv[s][mt], rhw, hwvo, mt * 16 * D + s * 32, 0);
        __syncthreads();
#pragma unroll
        for (int mt = 0; mt < 2; ++mt) {
#pragma unroll
            for (int nt = 0; nt < 3; ++nt)
#pragma unroll
                for (int j = 0; j < 4; ++j) part[(wid * 32 + mt * 16 + 4 * G + j) * 48 + nt * 16 + i16] = acc[mt][nt][j];
            float s = ssq[mt]; s += __shfl_xor(s, 16); s += __shfl_xor(s, 32);
            if (G == 0) pss[wid * 32 + mt * 16 + i16] = s;
        }
        __syncthreads();
        if (tid < 32) {
            const int tok = row0 + tid;
            float ssum = 0.f;
#pragma unroll
            for (int w = 0; w < 8; ++w) ssum += pss[w * 32 + tid];
            const float rr = rsqrtf(ssum * (1.0f / D) + EPS);
            float lg[4];
#pragma unroll
            for (int j = 0; j < 4; ++j) { float s = 0.f;
#pragma unroll
                for (int w = 0; w < 8; ++w) s += part[(w * 32 + tid) * 48 + 32 + j];
                lg[j] = s * rr + p.b_rg[j]; }
            int g = 0; float gm = lg[0];
#pragma unroll
            for (int j = 1; j < 4; ++j) if (lg[j] > gm) { gm = lg[j]; g = j; }
            float gs = 0.f;
#pragma unroll
            for (int j = 0; j < 4; ++j) gs += __expf(lg[j] - gm);
            const float gw = 1.0f / gs;
            float le[8];
#pragma unroll
            for (int j = 0; j < 8; ++j) { float s = 0.f;
#pragma unroll
                for (int w = 0; w < 8; ++w) s += part[(w * 32 + tid) * 48 + g * 8 + j];
                le[j] = s * rr + p.b_re[g * 8 + j]; }
            int j1 = 0; float l1 = le[0];
#pragma unroll
            for (int j = 1; j < 8; ++j) if (le[j] > l1) { l1 = le[j]; j1 = j; }
            int j2 = -1; float l2 = -3.0e38f;
#pragma unroll
            for (int j = 0; j < 8; ++j) if (j != j1 && le[j] > l2) { l2 = le[j]; j2 = j; }
            const float w1 = gw / (1.0f + __expf(l2 - l1)), w2 = gw - w1;
            const int e1 = g * 8 + j1, e2 = g * 8 + j2;
            const int p1 = atomicAdd(&p.cnt[e1 * 32], 1), p2 = atomicAdd(&p.cnt[e2 * 32], 1);
            p.tok_list[e1 * T + p1] = tok; p.w_list[e1 * T + p1] = w1; p.rr_list[e1 * T + p1] = rr;
            p.tok_list[e2 * T + p2] = tok; p.w_list[e2 * T + p2] = w2; p.rr_list[e2 * T + p2] = rr;
            *(int4*)(p.asg + tok * 4) = make_int4(e1, p1, e2, p2);
        }
        __syncthreads();
    }
}

struct MoeMap { int* cnt; int* seg; int* cum; };
__device__ __forceinline__ MoeMap moe_map(const Params& p, char* smem, const int wv) {
    MoeMap mm; mm.cnt = (int*)(smem + 2 * STAGE_B); mm.seg = mm.cnt + 32; mm.cum = mm.seg + 36;
    __syncthreads();
    if (tid_of(wv) == 0) {
        int s = 0, c = 0;
        for (int e = 0; e < NE; ++e) { const int n = p.cnt[e * 32]; mm.cnt[e] = n; mm.seg[e] = s; mm.cum[e] = c; const int nt = (n + 255) >> 8; s += nt * 256; c += nt; }
        mm.seg[NE] = s; mm.cum[NE] = c;
    }
    __syncthreads();
    return mm;
}
__device__ __forceinline__ bool moe_tile(const MoeMap& mm, const int wv, int i, int& e, int& mt, int& nt) {
    const int c = mm.cum[1 + (opq(tid_of(wv)) & 31)];
    const unsigned done_mask = (unsigned)__ballot(i >= c * 8);
    if (done_mask >> 31) return false;
    const int ee = __popc(done_mask);
    const int j = i - mm.cum[ee] * 8, nm = mm.cum[ee + 1] - mm.cum[ee];
    e = ee; nt = j / nm; mt = j - nt * nm; return true;
}

template <class P_> __device__ __forceinline__ P_* opq_s(P_* q) { asm volatile("" : "+s"(q)); return q; }
__device__ __forceinline__ int4 moe_gather(const Params& p, const int tid, const int e, const int mt, const int cnt) {
    int R0, C0; stage_rcx(tid, R0, C0); int pos; int4 av;
    pos = mt * 256 + R0;       pos = pos < cnt ? pos : cnt - 1; av.x = p.tok_list[e * T + pos] * D + C0;
    pos = mt * 256 + R0 + 64;  pos = pos < cnt ? pos : cnt - 1; av.y = p.tok_list[e * T + pos] * D + C0;
    pos = mt * 256 + R0 + 128; pos = pos < cnt ? pos : cnt - 1; av.z = p.tok_list[e * T + pos] * D + C0;
    pos = mt * 256 + R0 + 192; pos = pos < cnt ? pos : cnt - 1; av.w = p.tok_list[e * T + pos] * D + C0;
    return av;
}
__device__ __forceinline__ void moe_wait_done(const Params& p, const int wv, const int e, const int cnt) {
    if (tid_of(wv) == 0) {
        const int need = ((cnt + 255) >> 8) * 8;
        unsigned spins = 0;
        while (__hip_atomic_load(&p.done[e * 32], __ATOMIC_RELAXED, __HIP_MEMORY_SCOPE_AGENT) < need) { __builtin_amdgcn_s_sleep(8); if (++spins > (1u << 22)) break; }
        __builtin_amdgcn_fence(__ATOMIC_ACQUIRE, "agent");
        asm volatile("s_waitcnt vmcnt(0)" ::: "memory");
    }
    __syncthreads();
}
__device__ void phase56(const Params& p, char* smem, const int wv) {
    const int xcd = blockIdx.x & 7, slot = blockIdx.x >> 3;
    const MoeMap mm = moe_map(p, smem, wv);
    if (slot >= 32) return;
    const int half = wv >> 2;
    const int n5 = mm.cum[NE] * 8;
    u32x4 sb[4][2];
#define ra5 mk_rsrc4(opq_s(p.hw))
#define ra6 mk_rsrc4(opq_s(p.hbuf))
    int L = (((slot >> 4) * 8 + xcd) << 4) + (slot & 15);
    int e, mt, nt;
    bool down = L >= n5;
    if (!moe_tile(mm, wv, down ? L - n5 : L, e, mt, nt)) return;
    e = __builtin_amdgcn_readfirstlane(e); mt = __builtin_amdgcn_readfirstlane(mt); nt = __builtin_amdgcn_readfirstlane(nt);
    int4 av = make_int4(0, 0, 0, 0); int avo0 = 0;
    {
        const int tid = opq(tid_of(wv));
        const int cnt = __builtin_amdgcn_readfirstlane(mm.cnt[e]), seg = __builtin_amdgcn_readfirstlane(mm.seg[e]);
        __amdgpu_buffer_rsrc_t rb; int bvo, ldb4; moe_rb(p, tid, half, down, e, nt, rb, bvo, ldb4);
        moe_load_b(rb, bvo, ldb4, 0, sb);
        if (!down) av = moe_gather(p, tid, e, mt, cnt);
        else { moe_wait_done(p, wv, e, cnt); int R0, C0; stage_rcx(tid, R0, C0); avo0 = (seg + mt * 256 + R0) * FF + C0; }
        moe_write0(tid, smem, sb);
        if (!down) moe_dma_a0<true>(tid, ra5, 0, 0, av, smem); else moe_dma_a0<false>(tid, ra6, avo0, 64 * FF, av, smem);
        moe_load_b(rb, bvo, ldb4, 1, sb);
    }
    for (;;) {
        const int cnt = __builtin_amdgcn_readfirstlane(mm.cnt[e]), seg = __builtin_amdgcn_readfirstlane(mm.seg[e]);
        const int L2 = L + 256; const bool down2 = L2 >= n5;
        int e2 = 0, mt2 = 0, nt2 = 0;
        const bool more = moe_tile(mm, wv, down2 ? L2 - n5 : L2, e2, mt2, nt2);
        e2 = __builtin_amdgcn_readfirstlane(e2); mt2 = __builtin_amdgcn_readfirstlane(mt2); nt2 = __builtin_amdgcn_readfirstlane(nt2);
        const int tid = opq(tid_of(wv));
        __amdgpu_buffer_rsrc_t rb; int bvo, ldb4;
        moe_rb(p, tid, half, down, e, nt, rb, bvo, ldb4);
        f32x16 acc[4][2];
#pragma unroll
        for (int m = 0; m < 4; ++m)
#pragma unroll
            for (int n = 0; n < 2; ++n)
#pragma unroll
                for (int r = 0; r < 16; ++r) acc[m][n][r] = 0.f;
        if (!down) gemm_kloop<true>(tid, ra5, 0, 0, av, rb, bvo, ldb4, D / 64, smem, sb, acc, p, wv, more ? down2 : down, more ? e2 : e, more ? nt2 : nt);
        else gemm_kloop<false>(tid, ra6, avo0, 64 * FF, av, rb, bvo, ldb4, FF / 64, smem, sb, acc, p, wv, more ? down2 : down, more ? e2 : e, more ? nt2 : nt);
        const int t2 = opq(tid_of(wv)), wid2 = t2 >> 6, lane2 = t2 & 63; const int wr = wid2 >> 2, wc = wid2 & 3, jr = lane2 & 31, hl = lane2 >> 5;
        float ev[4];
#pragma unroll
        for (int m = 0; m < 4; ++m) { const int rl = mt * 256 + wr * 128 + m * 32 + jr;
            ev[m] = (down ? (rl < cnt ? p.w_list[e * T + rl] : 0.f) : p.rr_list[e * T + (rl < cnt ? rl : cnt - 1)]) * WINV; }
        const bool defer = more && down2 && !down;
        int4 av2 = make_int4(0, 0, 0, 0); int avo02 = 0;
        if (more) {
            const int cnt2 = __builtin_amdgcn_readfirstlane(mm.cnt[e2]), seg2 = __builtin_amdgcn_readfirstlane(mm.seg[e2]);
            if (!down2) av2 = moe_gather(p, t2, e2, mt2, cnt2);
            moe_write0(t2, smem, sb);
            if (!defer) {
                if (!down2) moe_dma_a0<true>(t2, ra5, 0, 0, av2, smem);
                else { moe_wait_done(p, wv, e2, cnt2); int R0, C0; stage_rcx(t2, R0, C0); avo02 = (seg2 + mt2 * 256 + R0) * FF + C0; moe_dma_a0<false>(t2, ra6, avo02, 64 * FF, av2, smem); }
            }
            { __amdgpu_buffer_rsrc_t rb2; int bvo2, ldb42; moe_rb(p, t2, half, down2, e2, nt2, rb2, bvo2, ldb42); moe_load_b(rb2, bvo2, ldb42, 1, sb); }
        }
        __builtin_amdgcn_sched_barrier(0);
        if (!down) {
            const __amdgpu_buffer_rsrc_t rh = mk_rsrc(opq_s(p.hbuf));
#pragma unroll
            for (int m = 0; m < 4; ++m) {
                const int rl = mt * 256 + wr * 128 + m * 32 + jr;
                const float rr = ev[m];
                const int ob = (seg + rl) * FF + nt * 128 + wc * 32 + 16 * hl;
                float hv[16];
#pragma unroll
                for (int r = 0; r < 16; ++r) { const float gte = acc[m][0][r] * rr, upv = acc[m][1][r] * rr; hv[r] = gte / (1.0f + __expf(-gte)) * upv; }
                u32x4 o; o.x = pk8(hv[0], hv[1], hv[2], hv[3]); o.y = pk8(hv[4], hv[5], hv[6], hv[7]); o.z = pk8(hv[8], hv[9], hv[10], hv[11]); o.w = pk8(hv[12], hv[13], hv[14], hv[15]);
                __builtin_amdgcn_raw_buffer_store_b128(o, rh, ob, 0, 16);
                __builtin_amdgcn_sched_barrier(0);
            }
            asm volatile("s_waitcnt vmcnt(0)" ::: "memory");
            __syncthreads();
            if (tid_of(wv) == 0) (void)__hip_atomic_fetch_add(&p.done[e * 32], 1, __ATOMIC_RELAXED, __HIP_MEMORY_SCOPE_AGENT);
        } else {
#pragma unroll
            for (int m = 0; m < 4; ++m) {
                const int rl = mt * 256 + wr * 128 + m * 32 + jr;
                const float w = ev[m] * YSCALE;
                unsigned char* rowp = (unsigned char*)p.ybuf + (size_t)(seg + rl) * D + nt * 256 + wc * 64 + 16 * hl;
#pragma unroll
                for (int n = 0; n < 2; ++n) {
                    u32x4 o;
                    o.x = pk8(acc[m][n][0] * w, acc[m][n][1] * w, acc[m][n][2] * w, acc[m][n][3] * w); o.y = pk8(acc[m][n][4] * w, acc[m][n][5] * w, acc[m][n][6] * w, acc[m][n][7] * w);
                    o.z = pk8(acc[m][n][8] * w, acc[m][n][9] * w, acc[m][n][10] * w, acc[m][n][11] * w); o.w = pk8(acc[m][n][12] * w, acc[m][n][13] * w, acc[m][n][14] * w, acc[m][n][15] * w);
                    *(u32x4*)(rowp + n * 32) = o;
                }
            }
        }
        if (!more) break;
        if (defer) {
            const int cnt2 = __builtin_amdgcn_readfirstlane(mm.cnt[e2]), seg2 = __builtin_amdgcn_readfirstlane(mm.seg[e2]);
            moe_wait_done(p, wv, e2, cnt2);
            const int t3 = opq(tid_of(wv)); int R0, C0; stage_rcx(t3, R0, C0); avo02 = (seg2 + mt2 * 256 + R0) * FF + C0;
            moe_dma_a0<false>(t3, ra6, avo02, 64 * FF, av2, smem);
        }
        L = L2; down = down2; e = e2; mt = mt2; nt = nt2; av = av2; avo0 = avo02;
    }
#undef ra5
#undef ra6
}

__device__ void phase7(const Params& p, char* smem, const int wv) {
    const int tid = opq(tid_of(wv)), wid = tid >> 6, lane = tid & 63;
    const MoeMap mm = moe_map(p, smem, wv);
    typedef float f32x2_t __attribute__((ext_vector_type(2)));
    for (int tok = blockIdx.x * 8 + wid; tok < T; tok += gridDim.x * 8) {
        const int4 a = *(const int4*)(p.asg + tok * 4);
        const unsigned char* ya = (const unsigned char*)p.ybuf + (size_t)(mm.seg[a.x] + a.y) * D;
        const unsigned char* yb = (const unsigned char*)p.ybuf + (size_t)(mm.seg[a.z] + a.w) * D;
        const bf16_t* hb = p.h2b + (size_t)tok * D;
        float* o = p.out + (size_t)tok * D;
        u32x4 h[2][2], u1[2], u2[2];
#pragma unroll
        for (int i = 0; i < 2; ++i) { const int c = 16 * (lane + 64 * i); h[i][0] = *(const u32x4*)(hb + c); h[i][1] = *(const u32x4*)(hb + c + 8);
            u1[i] = *(const u32x4*)(ya + c); u2[i] = *(const u32x4*)(yb + c); }
#pragma unroll
        for (int i = 0; i < 2; ++i) { const int c = 16 * (lane + 64 * i);
#pragma unroll
            for (int q = 0; q < 4; ++q) {
                const f32x2_t a01 = __builtin_amdgcn_cvt_pk_f32_fp8((int)u1[i][q], false), a23 = __builtin_amdgcn_cvt_pk_f32_fp8((int)u1[i][q], true);
                const f32x2_t b01 = __builtin_amdgcn_cvt_pk_f32_fp8((int)u2[i][q], false), b23 = __builtin_amdgcn_cvt_pk_f32_fp8((int)u2[i][q], true);
                const unsigned hA = h[i][q >> 1][(2 * q) & 3], hB = h[i][q >> 1][(2 * q + 1) & 3];
                f32x4 v;
                v[0] = bf_lo(hA) + (a01[0] + b01[0]) * YINV; v[1] = bf_hi(hA) + (a01[1] + b01[1]) * YINV;
                v[2] = bf_lo(hB) + (a23[0] + b23[0]) * YINV; v[3] = bf_hi(hB) + (a23[1] + b23[1]) * YINV;
                *(f32x4*)(o + c + 4 * q) = v;
            }
        }
    }
}

template <int PH> __device__ __forceinline__ void run_phase(const Params& p, char* smem, const int wv) {
    if (PH == 0) phase0(p, smem, wv); else if (PH == 1) phase1(p, smem, wv); else if (PH == 2) phase2(p, smem, wv); else if (PH == 3) phase3(p, smem, wv);
    else if (PH == 4) phase4(p, smem, wv); else if (PH == 5) phase56(p, smem, wv); else phase7(p, smem, wv);
}
#if N_LAUNCH_SPLIT
template <int PH> __global__ void __launch_bounds__(512) ph_kernel(Params p) {
    __shared__ __attribute__((aligned(1024))) char smem[SMEM_BYTES];
    run_phase<PH>(p, smem, __builtin_amdgcn_readfirstlane(threadIdx.x >> 6));
}
#else
__global__ void __launch_bounds__(512) fwd_kernel(Params p) {
    __shared__ __attribute__((aligned(1024))) char smem[SMEM_BYTES];
    volatile LAS unsigned* st = (volatile LAS unsigned*)(smem + SMEM_BYTES - 16);
    const int wv = __builtin_amdgcn_readfirstlane(threadIdx.x >> 6);
    if (tid_of(wv) == 0) { st[0] = 0u; st[1] = 0u; }
    __syncthreads();
    const XcdBarrier xb = xcd_barrier_post(p.bar, st, wv);
#ifndef PROBE_DUP
#define PROBE_DUP -1
#endif
#define RUNP(n) do { run_phase<n>(p, smem, wv); xcd_barrier(xb, wv); if (PROBE_DUP == n) { run_phase<n>(p, smem, wv); xcd_barrier(xb, wv); } } while (0)
    RUNP(0); RUNP(1); RUNP(2); RUNP(3); RUNP(4); RUNP(5);
    run_phase<7>(p, smem, wv);
}
#endif

extern "C" void kernel_launch(void* const* d_in, const int* in_sizes, int n_in, void* d_out, int out_size, void* d_ws, size_t ws_size, hipStream_t stream) {
    (void)in_sizes; (void)n_in; (void)out_size; (void)ws_size;
    Params p{};
    p.x = (const float*)d_in[0]; p.meta = (const float*)d_in[1]; p.mix_w = (const float*)d_in[2]; p.w_in = (const float*)d_in[3];
    p.qn_w = (const float*)d_in[4]; p.kn_w = (const float*)d_in[5]; p.rel_bias = (const float*)d_in[6]; p.meta_bias = (const float*)d_in[7];
    p.conv_w = (const float*)d_in[8]; p.an_w = (const float*)d_in[9]; p.cn_w = (const float*)d_in[10]; p.w_out = (const float*)d_in[11];
    p.ffn_w = (const float*)d_in[12]; p.w_rg = (const float*)d_in[13]; p.b_rg = (const float*)d_in[14]; p.w_re = (const float*)d_in[15];
    p.b_re = (const float*)d_in[16]; p.w_gate = (const float*)d_in[17]; p.w_up = (const float*)d_in[18]; p.w_down = (const float*)d_in[19];
    p.out = (float*)d_out;
    char* ws = (char*)d_ws; size_t off = 0;
    auto take = [&](size_t bytes) { char* r = ws + off; off += (bytes + 4095) & ~(size_t)4095; return r; };
    p.bar = (unsigned*)take(16384);
    p.cnt = (int*)take(8192);
    p.done = p.cnt + 1024;
    const size_t zero_bytes = off;
    p.xn = (bf16_t*)take((size_t)T * D * 2);
    p.proj = (bf16_t*)take((size_t)T * PROJ * 2);
    p.metaproj = (float*)take(16 * 4096 * 4);
    p.wrt = (bf16_t*)take(2 * 48 * 2048 * 2);
    p.wib = (bf16_t*)take((size_t)D * PROJ * 2);
    p.wob = (bf16_t*)take((size_t)D * D * 2);
    p.mixed = (bf16_t*)take((size_t)T * D * 2);
    p.ss = (float*)take((size_t)T * SSW * 4);
    p.hw = (bf16_t*)take((size_t)T * D * 2);
    p.h2b = p.xn;
    p.rr_list = (float*)take(NE * T * 4);
    p.asg = (int*)take(T * 16);
    p.tok_list = (int*)take(NE * T * 4);
    p.w_list = (float*)take(NE * T * 4);
    p.hbuf = (bf16_t*)take((size_t)HROWS * FF * 2);
    p.ybuf = (bf16_t*)take((size_t)HROWS * D * 2);
    (void)hipMemsetAsync(d_ws, 0, zero_bytes, stream);
    const int grid = 256;
#if N_LAUNCH_SPLIT
    hipLaunchKernelGGL(ph_kernel<0>, dim3(grid), dim3(512), 0, stream, p);
    hipLaunchKernelGGL(ph_kernel<1>, dim3(grid), dim3(512), 0, stream, p);
    hipLaunchKernelGGL(ph_kernel<2>, dim3(grid), dim3(512), 0, stream, p);
    hipLaunchKernelGGL(ph_kernel<3>, dim3(grid), dim3(512), 0, stream, p);
    hipLaunchKernelGGL(ph_kernel<4>, dim3(grid), dim3(512), 0, stream, p);
    hipLaunchKernelGGL(ph_kernel<5>, dim3(grid), dim3(512), 0, stream, p);
    hipLaunchKernelGGL(ph_kernel<7>, dim3(grid), dim3(512), 0, stream, p);
#else
    void* args[] = {&p};
    hipError_t e = hipLaunchCooperativeKernel((const void*)fwd_kernel, dim3(grid), dim3(512), args, 0, stream);
    if (e != hipSuccess) fprintf(stderr, "cooperative launch failed: %s\n", hipGetErrorString(e));
#endif
}
```
